# Optimizing an MI355X kernel written in HIP

```python
import math
import jax, jax.numpy as jnp
from jax import lax
import numpy as np

D_MODEL = 1024
BATCH = 4
SEQ = 8192
DEPTH = 2

CHUNK = 64
MIX_WIDTH = D_MODEL
GMLP_WIDTH = MIX_WIDTH // 2
GMLP_GROUPS = 4
GMLP_GROUP_DIM = GMLP_WIDTH // GMLP_GROUPS
GMLP_BLOCK = 128
DIFF_WIDTH = MIX_WIDTH - GMLP_WIDTH
DIFF_HEADS = 4
DIFF_VDIM = DIFF_WIDTH // DIFF_HEADS
DIFF_QK_DIM = DIFF_VDIM // 2
ROPE_THETA = 10000.0
QBLK = 128
FFN_HIDDEN = int(math.ceil(8 * D_MODEL / 3 / 256)) * 256
Q_WIDTH = DIFF_HEADS * 2 * DIFF_QK_DIM
K_WIDTH = DIFF_HEADS * 2 * DIFF_QK_DIM
IN_WIDTH = 2 * GMLP_WIDTH + Q_WIDTH + K_WIDTH + DIFF_WIDTH
NORM_EPS = 1e-6
NEG_INF = -1e30

kernel_name = "hybrid_gmlp_diffattn_sandwich"


def rms_norm(x, g, eps=NORM_EPS):
    xf = x.astype(jnp.float32)
    y = xf * lax.rsqrt(jnp.mean(xf * xf, axis=-1, keepdims=True) + eps)
    return (y * g.astype(jnp.float32)).astype(x.dtype)


def layer_norm(x, g, b, eps=NORM_EPS):
    xf = x.astype(jnp.float32)
    mu = jnp.mean(xf, axis=-1, keepdims=True)
    xc = xf - mu
    y = xc * lax.rsqrt(jnp.mean(xc * xc, axis=-1, keepdims=True) + eps)
    return (y * g.astype(jnp.float32) + b.astype(jnp.float32)).astype(x.dtype)


def rope_tables(seq, dim):
    inv = 1.0 / (ROPE_THETA ** (jnp.arange(0, dim, 2, dtype=jnp.float32) / dim))
    ang = jnp.arange(seq, dtype=jnp.float32)[:, None] * inv[None, :]
    return jnp.cos(ang), jnp.sin(ang)


def apply_rope(x, cos, sin):
    xf = x.astype(jnp.float32)
    half = xf.shape[-1] // 2
    x1, x2 = xf[..., :half], xf[..., half:]
    c = cos[:, None, None, :]
    s = sin[:, None, None, :]
    return jnp.concatenate([x1 * c - x2 * s, x2 * c + x1 * s], axis=-1).astype(x.dtype)


def gmlp_mixer(u, v, ln_g, ln_b, ws, bias):
    bsz, seq, _ = u.shape
    n = seq // GMLP_BLOCK
    v = layer_norm(v, ln_g, ln_b)
    v = v.reshape(bsz, n, GMLP_BLOCK, GMLP_GROUPS, GMLP_GROUP_DIM)
    t_chunk = jnp.arange(GMLP_BLOCK) // CHUNK
    mask = t_chunk[None, :] <= t_chunk[:, None]
    w = jnp.where(mask[None], ws, jnp.zeros_like(ws)).astype(v.dtype)
    mixed = jnp.einsum('gts,bnsgc->bntgc', w, v)
    mixed = mixed + jnp.transpose(bias)[:, :, None].astype(v.dtype)
    out = u.reshape(bsz, n, GMLP_BLOCK, GMLP_GROUPS, GMLP_GROUP_DIM) * mixed
    return out.reshape(bsz, seq, GMLP_WIDTH)


def diff_attention(q, k, v, cos, sin, lam, lam_init, subln_g):
    bsz, seq, _ = q.shape
    q = q.reshape(bsz, seq, DIFF_HEADS, 2, DIFF_QK_DIM)
    k = k.reshape(bsz, seq, DIFF_HEADS, 2, DIFF_QK_DIM)
    v = v.reshape(bsz, seq, DIFF_HEADS, DIFF_VDIM)
    q = apply_rope(q, cos, sin) * (DIFF_QK_DIM ** -0.5)
    k = apply_rope(k, cos, sin)
    k_chunk = jnp.arange(seq) // CHUNK
    n_blk = seq // QBLK

    def block(i):
        qb = lax.dynamic_slice_in_dim(q, i * QBLK, QBLK, axis=1)
        s = jnp.einsum('bqhjd,bkhjd->jbhqk', qb, k).astype(jnp.float32)
        q_chunk = (i * QBLK + jnp.arange(QBLK)) // CHUNK
        mask = k_chunk[None, :] <= q_chunk[:, None]
        s = jnp.where(mask, s, NEG_INF)
        p = jax.nn.softmax(s, axis=-1)
        a = p[0] - lam * p[1]
        return jnp.einsum('bhqk,bkhe->bqhe', a.astype(v.dtype), v)

    o = lax.map(block, jnp.arange(n_blk))
    o = jnp.transpose(o, (1, 0, 2, 3, 4)).reshape(bsz, seq, DIFF_HEADS, DIFF_VDIM)
    o = rms_norm(o, subln_g) * (1.0 - lam_init)
    return o.reshape(bsz, seq, DIFF_WIDTH).astype(q.dtype)


def setup_inputs(seed: int = 0) -> dict:
    key = jax.random.key(seed)
    ks = jax.random.split(key, 24)
    f32 = jnp.float32
    nrm = lambda k, shape, scale: jax.random.normal(k, shape, f32) * scale
    gain = lambda k, shape: 1.0 + 0.05 * jax.random.normal(k, shape, f32)
    return {
        "x": jax.random.normal(ks[0], (BATCH, SEQ, D_MODEL), f32),
        "pre_mix_g": gain(ks[1], (DEPTH, D_MODEL)),
        "w_in": nrm(ks[2], (DEPTH, D_MODEL, IN_WIDTH), D_MODEL ** -0.5),
        "gmlp_ln_g": gain(ks[3], (DEPTH, GMLP_WIDTH)),
        "gmlp_ln_b": nrm(ks[4], (DEPTH, GMLP_WIDTH), 0.02),
        "gmlp_ws": nrm(ks[5], (DEPTH, GMLP_GROUPS, GMLP_BLOCK, GMLP_BLOCK), GMLP_BLOCK ** -0.5),
        "gmlp_b": gain(ks[6], (DEPTH, GMLP_GROUPS, GMLP_BLOCK)),
        "lambda_q1": nrm(ks[7], (DEPTH, DIFF_QK_DIM), 0.1),
        "lambda_k1": nrm(ks[8], (DEPTH, DIFF_QK_DIM), 0.1),
        "lambda_q2": nrm(ks[9], (DEPTH, DIFF_QK_DIM), 0.1),
        "lambda_k2": nrm(ks[10], (DEPTH, DIFF_QK_DIM), 0.1),
        "subln_g": gain(ks[11], (DEPTH, DIFF_VDIM)),
        "w_out": nrm(ks[12], (DEPTH, MIX_WIDTH, D_MODEL), MIX_WIDTH ** -0.5),
        "post_mix_g": gain(ks[13], (DEPTH, D_MODEL)),
        "pre_ffn_g": gain(ks[14], (DEPTH, D_MODEL)),
        "w_gate_up": nrm(ks[15], (DEPTH, D_MODEL, 2 * FFN_HIDDEN), D_MODEL ** -0.5),
        "w_down": nrm(ks[16], (DEPTH, FFN_HIDDEN, D_MODEL), FFN_HIDDEN ** -0.5),
        "post_ffn_g": gain(ks[17], (DEPTH, D_MODEL)),
    }


def reference(x, pre_mix_g, w_in, gmlp_ln_g, gmlp_ln_b, gmlp_ws, gmlp_b,
              lambda_q1, lambda_k1, lambda_q2, lambda_k2, subln_g, w_out,
              post_mix_g, pre_ffn_g, w_gate_up, w_down, post_ffn_g):
    seq = x.shape[1]
    cos, sin = rope_tables(seq, DIFF_QK_DIM)
    o_u = 0
    o_v = GMLP_WIDTH
    o_q = 2 * GMLP_WIDTH
    o_k = o_q + Q_WIDTH
    o_val = o_k + K_WIDTH
    for l in range(DEPTH):
        h = rms_norm(x, pre_mix_g[l])
        z = jnp.einsum('bsd,de->bse', h, w_in[l])
        uv = jax.nn.gelu(z[..., o_u:o_q], approximate=False)
        u, v_g = uv[..., :GMLP_WIDTH], uv[..., GMLP_WIDTH:]
        y_a = gmlp_mixer(u, v_g, gmlp_ln_g[l], gmlp_ln_b[l], gmlp_ws[l], gmlp_b[l])

        lam_init = 0.8 - 0.6 * math.exp(-0.3 * l)
        lam = (jnp.exp(jnp.sum(lambda_q1[l].astype(jnp.float32) * lambda_k1[l].astype(jnp.float32)))
               - jnp.exp(jnp.sum(lambda_q2[l].astype(jnp.float32) * lambda_k2[l].astype(jnp.float32)))
               + lam_init)
        y_b = diff_attention(z[..., o_q:o_k], z[..., o_k:o_val], z[..., o_val:],
                             cos, sin, lam, lam_init, subln_g[l])

        mix = jnp.einsum('bse,ed->bsd', jnp.concatenate([y_a, y_b], axis=-1), w_out[l])
        x = x + rms_norm(mix, post_mix_g[l])

        h = rms_norm(x, pre_ffn_g[l])
        gu = jnp.einsum('bsd,df->bsf', h, w_gate_up[l])
        gate, up = gu[..., :FFN_HIDDEN], gu[..., FFN_HIDDEN:]
        y = jnp.einsum('bsf,fd->bsd', jax.nn.silu(gate) * up, w_down[l])
        x = x + rms_norm(y, post_ffn_g[l])
    return x
```

```cpp
#include <hip/hip_runtime.h>
#include <cstdio>
#include <cstdint>
#include <cmath>
namespace pg8 {
#define PG8_LAS __attribute__((address_space(3)))
typedef unsigned short bf16_t;
typedef short bf16x8 __attribute__((ext_vector_type(8)));
typedef float f32x4 __attribute__((ext_vector_type(4)));
typedef unsigned u32x4 __attribute__((ext_vector_type(4)));
constexpr int BM = 256, BK = 64, HALF = 128, HTB = HALF * BK * 2  , STAGE_BYTES = 8 * HTB, NXCD = 8, WGM = 4;

__host__ __device__ __forceinline__ int lds_byte(int r, int c) { const int st = (r >> 4) * 2 + (c >> 5), rr = r & 15, cc = c & 31, ob = rr * 64 + cc * 2; return st * 1024 + (ob ^ (((ob >> 9) & 1) << 5)); }
__host__ __device__ __forceinline__ void stage_rc(int b, int& R, int& C) { const int st = b / 1024, sb = b % 1024, swz = sb ^ (((sb >> 9) & 1) << 5); R = (st >> 1) * 16 + swz / 64; C = (st & 1) * 32 + (swz % 64) / 2; }
__host__ __device__ __forceinline__ int perm32(int rho) { const int n = rho >> 4, i = rho & 15; return 8 * (i >> 2) + 4 * n + (i & 3); }

struct Unit { int pm, pn; };
struct Gemm { const bf16_t* A; const bf16_t* Bt; int M, N, K; };

struct StaticOrder {
    int nM, nN, nwg, G, c;
    __host__ __device__ void init(int M, int N, int G_, int c_) { nM = M / BM; nN = N / BM; nwg = nM * nN; G = G_; c = c_; }
    __host__ __device__ bool next(int i, Unit& u) const {
        const long L = (long)i * G + c; if (L >= nwg) return false;
        int wgid = (int)L; { const int q = nwg / NXCD, r = nwg % NXCD, xcd = wgid % NXCD, off = wgid / NXCD; wgid = (xcd < r ? xcd * (q + 1) : r * (q + 1) + (xcd - r) * q) + off; }
        const int nig = WGM * nN, gid = wgid / nig, fm = gid * WGM, gsz = (nM - fm) < WGM ? (nM - fm) : WGM;
        u.pm = fm + ((wgid % nig) % gsz); u.pn = (wgid % nig) / gsz; return true;
    }
    __device__ __forceinline__ void a_ready(const Unit&) const {}
    __device__ __forceinline__ void done(const Unit&) const {}
};

__device__ __forceinline__ unsigned cvt_pk_bf16(float lo, float hi) { unsigned r; asm volatile("v_cvt_pk_bf16_f32 %0, %1, %2" : "=v"(r) : "v"(lo), "v"(hi)); return r; }
typedef float f32x2 __attribute__((ext_vector_type(2)));
__device__ __forceinline__ f32x2 gelu_pk(f32x2 v) {
    const f32x2 av = __builtin_elementwise_abs(v), d = av * 0.2316418882f + 1.0f;
    f32x2 t; t.x = __builtin_amdgcn_rcpf(d.x); t.y = __builtin_amdgcn_rcpf(d.y);
    f32x2 q = t * 0.5307027145f + (-0.7265760135f); q = q * t + 0.7107068705f; q = q * t + (-0.142248368f); q = q * t + 0.127414796f; q = q * t;
    const f32x2 s = (v * v) * (-0.72134752044f);
    f32x2 e; e.x = __builtin_amdgcn_exp2f(s.x); e.y = __builtin_amdgcn_exp2f(s.y);
    const f32x2 m = v * (q * e), r = v - m;
    f32x2 o; o.x = v.x < 0.f ? m.x : r.x; o.y = v.y < 0.f ? m.y : r.y; return o;
}


typedef unsigned u32x2 __attribute__((ext_vector_type(2)));
__device__ __forceinline__ float shx(float v, int m, int lane) { return __builtin_bit_cast(float, __builtin_amdgcn_ds_bpermute((lane ^ m) << 2, __builtin_bit_cast(int, v))); }
__device__ __forceinline__ unsigned pkbf(float lo, float hi) { unsigned r; asm("v_cvt_pk_bf16_f32 %0, %1, %2" : "=v"(r) : "v"(lo), "v"(hi)); return r; }
__device__ __forceinline__ u32x4 pack8(f32x4 a, f32x4 b) { u32x4 w; w.x = pkbf(a[0], a[1]); w.y = pkbf(a[2], a[3]); w.z = pkbf(b[0], b[1]); w.w = pkbf(b[2], b[3]); return w; }

struct EpiIn {
    static constexpr bool PERM = true, AFTER_DRAIN = false;
    bf16_t *U, *VG, *Q, *K; const float* rinv; const float* rope  ; float qscale;
    __device__ __forceinline__ void operator()(const f32x4 (&acc)[2][2][4][2], const Unit& u, int wr, int wc, int fr, int fq) const {
        const int sec = u.pn >> 1, half = u.pn & 1;
        const int row0 = u.pm * BM + wr * 64 + fr;
        if (sec < 2) {
            bf16_t* base = (sec == 0 ? U : VG) + half * 256 + wc * 32 + 8 * fq;
#pragma unroll
            for (int ai = 0; ai < 2; ++ai)
#pragma unroll
                for (int m = 0; m < 4; ++m) { const int row = row0 + ai * HALF + m * 16; const float rs = rinv[row]; bf16_t* rowp = base + (size_t)row * 512;
#pragma unroll
                    for (int bj = 0; bj < 2; ++bj) { f32x4 v0 = acc[ai][bj][m][0] * rs, v1 = acc[ai][bj][m][1] * rs;
                        f32x2 a = gelu_pk((f32x2){v0[0], v0[1]}), b = gelu_pk((f32x2){v0[2], v0[3]}), c = gelu_pk((f32x2){v1[0], v1[1]}), d = gelu_pk((f32x2){v1[2], v1[3]});
                        u32x4 w; w.x = pkbf(a.x, a.y); w.y = pkbf(b.x, b.y); w.z = pkbf(c.x, c.y); w.w = pkbf(d.x, d.y);
                        *(u32x4*)(rowp + bj * HALF) = w; } }
        } else {
            bf16_t* base = (sec == 2 ? Q : K) + half * 256 + wc * 64 + 8 * fq;
            const float sc = (sec == 2) ? qscale : 1.f;
#pragma unroll
            for (int ai = 0; ai < 2; ++ai)
#pragma unroll
                for (int m = 0; m < 4; ++m) { const int row = row0 + ai * HALF + m * 16; const float rs = rinv[row] * sc; bf16_t* rowp = base + (size_t)row * 512;
                    const f32x4* rp = (const f32x4*)(rope + ((size_t)(row & 8191) * 32 + 8 * fq) * 2);
                    const f32x4 r0 = rp[0], r1 = rp[1], r2 = rp[2], r3 = rp[3];
                    const f32x4 x1a = acc[ai][0][m][0] * rs, x1b = acc[ai][0][m][1] * rs, x2a = acc[ai][1][m][0] * rs, x2b = acc[ai][1][m][1] * rs;
                    f32x4 o1a, o1b, o2a, o2b;
                    o1a[0] = x1a[0] * r0[0] - x2a[0] * r0[1]; o2a[0] = x2a[0] * r0[0] + x1a[0] * r0[1];
                    o1a[1] = x1a[1] * r0[2] - x2a[1] * r0[3]; o2a[1] = x2a[1] * r0[2] + x1a[1] * r0[3];
                    o1a[2] = x1a[2] * r1[0] - x2a[2] * r1[1]; o2a[2] = x2a[2] * r1[0] + x1a[2] * r1[1];
                    o1a[3] = x1a[3] * r1[2] - x2a[3] * r1[3]; o2a[3] = x2a[3] * r1[2] + x1a[3] * r1[3];
                    o1b[0] = x1b[0] * r2[0] - x2b[0] * r2[1]; o2b[0] = x2b[0] * r2[0] + x1b[0] * r2[1];
                    o1b[1] = x1b[1] * r2[2] - x2b[1] * r2[3]; o2b[1] = x2b[1] * r2[2] + x1b[1] * r2[3];
                    o1b[2] = x1b[2] * r3[0] - x2b[2] * r3[1]; o2b[2] = x2b[2] * r3[0] + x1b[2] * r3[1];
                    o1b[3] = x1b[3] * r3[2] - x2b[3] * r3[3]; o2b[3] = x2b[3] * r3[2] + x1b[3] * r3[3];
                    *(u32x4*)(rowp) = pack8(o1a, o1b); *(u32x4*)(rowp + 32) = pack8(o2a, o2b); }
        }
    }
};
struct EpiVT {
    static constexpr bool PERM = true, AFTER_DRAIN = false;
    bf16_t* VT; int ldc; const float* rinv;
    __device__ __forceinline__ void operator()(const f32x4 (&acc)[2][2][4][2], const Unit& u, int wr, int wc, int fr, int fq) const {
        const int row0 = u.pm * BM + wr * 64 + fr, col0 = u.pn * BM + wc * 32 + 8 * fq;
        f32x4 rv[2][2];
#pragma unroll
        for (int bj = 0; bj < 2; ++bj)
#pragma unroll
            for (int n = 0; n < 2; ++n) rv[bj][n] = *(const f32x4*)(rinv + col0 + bj * HALF + 4 * n);
#pragma unroll
        for (int ai = 0; ai < 2; ++ai)
#pragma unroll
            for (int m = 0; m < 4; ++m) { bf16_t* rowp = VT + (size_t)(row0 + ai * HALF + m * 16) * ldc + col0;
#pragma unroll
                for (int bj = 0; bj < 2; ++bj) *(u32x4*)(rowp + bj * HALF) = pack8(acc[ai][bj][m][0] * rv[bj][0], acc[ai][bj][m][1] * rv[bj][1]); }
    }
};
struct EpiSS {
    static constexpr bool PERM = true, AFTER_DRAIN = false;
    bf16_t* O; float* ssp;
    __device__ __forceinline__ void operator()(const f32x4 (&acc)[2][2][4][2], const Unit& u, int wr, int wc, int fr, int fq) const {
        asm volatile("s_nop 15\n\ts_nop 7" ::: "memory");
        const int row0 = u.pm * BM + wr * 64 + fr, col0 = u.pn * BM + wc * 32 + 8 * fq;
#pragma unroll
        for (int ai = 0; ai < 2; ++ai)
#pragma unroll
            for (int m = 0; m < 4; ++m) { const int row = row0 + ai * HALF + m * 16; bf16_t* rowp = O + (size_t)row * 1024 + col0; float s = 0.f;
#pragma unroll
                for (int bj = 0; bj < 2; ++bj) { const f32x4 v0 = acc[ai][bj][m][0], v1 = acc[ai][bj][m][1];
                    s += (v0[0] * v0[0] + v0[1] * v0[1]) + (v0[2] * v0[2] + v0[3] * v0[3]) + (v1[0] * v1[0] + v1[1] * v1[1]) + (v1[2] * v1[2] + v1[3] * v1[3]);
                    *(u32x4*)(rowp + bj * HALF) = pack8(v0, v1); }
                { const int ln = fq * 16 + fr; s += shx(s, 16, ln); s += shx(s, 32, ln); }
                if (fq == 0) ssp[(size_t)row * 16 + u.pn * 4 + wc] = s; }
    }
};
struct EpiGU {
    static constexpr bool PERM = true, AFTER_DRAIN = false;
    bf16_t* H; int ldc; const float* rinv;
    __device__ __forceinline__ void operator()(const f32x4 (&acc)[2][2][4][2], const Unit& u, int wr, int wc, int fr, int fq) const {
        const int row0 = u.pm * BM + wr * 64 + fr, col0 = u.pn * HALF + wc * 32 + 8 * fq;
#pragma unroll
        for (int ai = 0; ai < 2; ++ai)
#pragma unroll
            for (int m = 0; m < 4; ++m) { const int row = row0 + ai * HALF + m * 16; const float rs = rinv[row]; f32x4 h[2];
#pragma unroll
                for (int n = 0; n < 2; ++n) { const f32x4 g = acc[ai][0][m][n] * rs, up = acc[ai][1][m][n] * rs;
#pragma unroll
                    for (int e = 0; e < 4; ++e) { const float ex = __builtin_amdgcn_exp2f(g[e] * -1.4426950408889634f); h[n][e] = g[e] * __builtin_amdgcn_rcpf(1.0f + ex) * up[e]; } }
                __builtin_nontemporal_store(pack8(h[0], h[1]), (u32x4*)(H + (size_t)row * ldc + col0)); }
    }
};
__device__ __forceinline__ int lane_id_opaque() { unsigned z = 0u; asm volatile("" : "+v"(z)); return (int)__builtin_amdgcn_mbcnt_hi(~0u, __builtin_amdgcn_mbcnt_lo(~0u, z)); }
template <class Epi, class Sched, bool ALIGN_EPI = false, bool SP2 = false>
__device__ __forceinline__ void gemm_phase(PG8_LAS unsigned char* lds, const Gemm g, const Sched& S, const Epi& E, int wid0) {
    int tid = wid0 * 64 + lane_id_opaque(); asm volatile("" : "+v"(tid));
    const int wid = __builtin_amdgcn_readfirstlane(tid >> 6), lane = tid & 63, wr = wid >> 2, wc = wid & 3, fr = lane & 15, fq = lane >> 4;
    const int K = g.K, nt = K / BK;
    unsigned voffA[2], voffB[2];
#pragma unroll
    for (int i = 0; i < 2; ++i) { int R, C; stage_rc(tid * 16 + i * 8192, R, C); const int Rb = Epi::PERM ? ((R & ~31) + perm32(R & 31)) : R;
        voffA[i] = (unsigned)(R * K + C) * 2u; voffB[i] = (unsigned)(Rb * K + C) * 2u; }
    const size_t kstep = (size_t)(BK * 2);
    const size_t hstep = (size_t)HALF * K * 2;
    const size_t tstep = 2 * hstep;
    const unsigned ldsw = (unsigned)wid * 1024u;
    const int aoff = lds_byte(wr * 64 + fr, fq * 8), boff = lds_byte(wc * 32 + fr, fq * 8);
#define PG8_SA(b, h) (((b) * 2 + (h)) * HTB)
#define PG8_SB(b, h) ((4 + (b) * 2 + (h)) * HTB)
#define PG8_STAGE(bufoff, gbase, voff) do { _Pragma("unroll") for (int _i = 0; _i < 2; ++_i) \
        __builtin_amdgcn_global_load_lds((const unsigned*)((const char*)(gbase) + (voff)[_i]), (PG8_LAS unsigned*)(lds + (bufoff) + ldsw + _i * 8192), 16, 0, 0); } while (0)
#define PG8_LDA(dst, b, h) do { _Pragma("unroll") for (int m = 0; m < 4; ++m) _Pragma("unroll") for (int k = 0; k < 2; ++k) dst[m][k] = *(const PG8_LAS bf16x8*)(lds + PG8_SA(b, h) + aoff + m * 2048 + k * 1024); } while (0)
#define PG8_LDB(dst, b, h) do { _Pragma("unroll") for (int n = 0; n < 2; ++n) _Pragma("unroll") for (int k = 0; k < 2; ++k) dst[n][k] = *(const PG8_LAS bf16x8*)(lds + PG8_SB(b, h) + boff + n * 2048 + k * 1024); } while (0)
#define PG8_MMA(ai, bj, At, Bt) do { __builtin_amdgcn_s_setprio(1); _Pragma("unroll") for (int m = 0; m < 4; ++m) _Pragma("unroll") for (int n = 0; n < 2; ++n) _Pragma("unroll") for (int k = 0; k < 2; ++k) \
        acc[ai][bj][m][n] = __builtin_amdgcn_mfma_f32_16x16x32_bf16(Bt[n][k], At[m][k], acc[ai][bj][m][n], 0, 0, 0); __builtin_amdgcn_s_setprio(0); } while (0)
#define PG8_WAIT_V(n) asm volatile("s_waitcnt vmcnt(" #n ")" ::: "memory")
#define PG8_WAIT_L(n) asm volatile("s_waitcnt lgkmcnt(" #n ")" ::: "memory")
#define PG8_BAR __builtin_amdgcn_s_barrier()
#define PG8_SCHED __builtin_amdgcn_sched_barrier(0)
    Unit cur, nxt; int ui = 0;
    if (!S.next(0, cur)) return;
    f32x4 acc[2][2][4][2];
#pragma unroll
    for (int a = 0; a < 2; ++a)
#pragma unroll
        for (int b = 0; b < 2; ++b)
#pragma unroll
            for (int m = 0; m < 4; ++m)
#pragma unroll
                for (int n = 0; n < 2; ++n) acc[a][b][m][n] = (f32x4){0.f, 0.f, 0.f, 0.f};
    bf16x8 At[4][2], B0[2][2], B1[2][2];
    const char* cA = (const char*)g.A + (size_t)cur.pm * tstep; const char* cB = (const char*)g.Bt + (size_t)cur.pn * tstep;
    S.a_ready(cur);
    if constexpr (SP2) {
        PG8_STAGE(PG8_SB(0, 0), cB, voffB); PG8_STAGE(PG8_SB(0, 1), cB + hstep, voffB); PG8_STAGE(PG8_SA(0, 0), cA, voffA); PG8_STAGE(PG8_SA(0, 1), cA + hstep, voffA);
        if (wr == 1) PG8_BAR;
        PG8_WAIT_V(2); PG8_BAR;
        PG8_STAGE(PG8_SB(1, 0), cB + kstep, voffB); PG8_STAGE(PG8_SA(1, 0), cA + kstep, voffA); PG8_STAGE(PG8_SB(1, 1), cB + hstep + kstep, voffB);
        PG8_WAIT_V(6); PG8_BAR;
    } else {
        PG8_STAGE(PG8_SB(0, 0), cB, voffB); PG8_STAGE(PG8_SA(0, 0), cA, voffA); PG8_STAGE(PG8_SB(0, 1), cB + hstep, voffB); PG8_STAGE(PG8_SA(0, 1), cA + hstep, voffA);
        if (wr == 1) PG8_BAR;
        PG8_WAIT_V(4); PG8_BAR;
        PG8_STAGE(PG8_SB(1, 0), cB + kstep, voffB); PG8_STAGE(PG8_SA(1, 0), cA + kstep, voffA); PG8_STAGE(PG8_SB(1, 1), cB + hstep + kstep, voffB);
        PG8_WAIT_V(6); PG8_BAR;
    }
    for (;;) {
        const bool has_next = S.next(ui + 1, nxt);
        const char* nA = has_next ? (const char*)g.A + (size_t)nxt.pm * tstep : cA; const char* nB = has_next ? (const char*)g.Bt + (size_t)nxt.pn * tstep : cB;
        for (int t = 0; t < nt; t += 2) {
            const bool last = (t == nt - 2);
            const char* a1 = cA + (size_t)(t + 1) * kstep;
            const char* a2 = last ? nA : cA + (size_t)(t + 2) * kstep; const char* b2 = last ? nB : cB + (size_t)(t + 2) * kstep;
            const char* a3 = a2 + kstep; const char* b3 = b2 + kstep;
            if (last && has_next) S.a_ready(nxt);
            if constexpr (SP2) {
            PG8_LDB(B0, 0, 0); PG8_LDB(B1, 0, 1); PG8_SCHED; PG8_LDA(At, 0, 0); PG8_STAGE(PG8_SA(1, 1), a1 + hstep, voffA);
            PG8_WAIT_V(8); PG8_WAIT_L(0); PG8_BAR; PG8_MMA(0, 0, At, B0); PG8_MMA(0, 1, At, B1); PG8_BAR; PG8_SCHED;
            PG8_LDA(At, 0, 1); PG8_STAGE(PG8_SB(0, 0), b2, voffB); PG8_STAGE(PG8_SB(0, 1), b2 + hstep, voffB); PG8_STAGE(PG8_SA(0, 0), a2, voffA);
            PG8_WAIT_V(8); PG8_WAIT_L(0); PG8_BAR; PG8_MMA(1, 0, At, B0); PG8_MMA(1, 1, At, B1); PG8_BAR; PG8_SCHED;
            PG8_LDB(B0, 1, 0); PG8_LDB(B1, 1, 1); PG8_SCHED; PG8_LDA(At, 1, 0); PG8_STAGE(PG8_SA(0, 1), a2 + hstep, voffA);
            PG8_WAIT_V(8); PG8_WAIT_L(0); PG8_BAR; PG8_MMA(0, 0, At, B0); PG8_MMA(0, 1, At, B1); PG8_BAR; PG8_SCHED;
            PG8_LDA(At, 1, 1); PG8_STAGE(PG8_SB(1, 0), b3, voffB); PG8_STAGE(PG8_SB(1, 1), b3 + hstep, voffB); PG8_STAGE(PG8_SA(1, 0), a3, voffA);
            PG8_WAIT_V(8); PG8_WAIT_L(0); PG8_BAR; PG8_MMA(1, 0, At, B0); PG8_MMA(1, 1, At, B1); PG8_BAR; PG8_SCHED;
            } else {
            PG8_LDB(B0, 0, 0); PG8_SCHED; PG8_LDA(At, 0, 0); PG8_STAGE(PG8_SA(1, 1), a1 + hstep, voffA);
            PG8_WAIT_L(8); PG8_BAR; PG8_WAIT_L(0); PG8_MMA(0, 0, At, B0); PG8_BAR; PG8_SCHED;
            PG8_LDB(B1, 0, 1); PG8_STAGE(PG8_SB(0, 0), b2, voffB);
            PG8_BAR; PG8_WAIT_L(0); PG8_MMA(0, 1, At, B1); PG8_BAR;
            PG8_LDA(At, 0, 1); PG8_STAGE(PG8_SA(0, 0), a2, voffA);
            PG8_BAR; PG8_WAIT_L(0); PG8_MMA(1, 0, At, B0); PG8_BAR; PG8_SCHED;
            PG8_STAGE(PG8_SB(0, 1), b2 + hstep, voffB);
            PG8_WAIT_V(6); PG8_BAR; PG8_MMA(1, 1, At, B1); PG8_BAR;
            PG8_LDB(B0, 1, 0); PG8_SCHED; PG8_LDA(At, 1, 0); PG8_STAGE(PG8_SA(0, 1), a2 + hstep, voffA);
            PG8_WAIT_L(8); PG8_BAR; PG8_WAIT_L(0); PG8_MMA(0, 0, At, B0); PG8_BAR; PG8_SCHED;
            PG8_LDB(B1, 1, 1); PG8_STAGE(PG8_SB(1, 0), b3, voffB);
            PG8_BAR; PG8_WAIT_L(0); PG8_MMA(0, 1, At, B1); PG8_BAR;
            PG8_LDA(At, 1, 1); PG8_STAGE(PG8_SA(1, 0), a3, voffA);
            PG8_BAR; PG8_WAIT_L(0); PG8_MMA(1, 0, At, B0); PG8_BAR; PG8_SCHED;
            PG8_STAGE(PG8_SB(1, 1), b3 + hstep, voffB);
            PG8_WAIT_V(6); PG8_BAR; PG8_MMA(1, 1, At, B1); PG8_BAR;
            }
        }
        if constexpr (ALIGN_EPI) { if (wr == 0) PG8_BAR; }
        if constexpr (!Epi::AFTER_DRAIN) { E(acc, cur, wr, wc, fr, fq); S.done(cur); }
        if (!has_next) break;
#pragma unroll
        for (int a = 0; a < 2; ++a)
#pragma unroll
            for (int b = 0; b < 2; ++b)
#pragma unroll
                for (int m = 0; m < 4; ++m)
#pragma unroll
                    for (int n = 0; n < 2; ++n) acc[a][b][m][n] = (f32x4){0.f, 0.f, 0.f, 0.f};
        cur = nxt; cA = nA; cB = nB; ++ui;
        if constexpr (ALIGN_EPI) { if (wr == 1) PG8_BAR; }
    }
    PG8_WAIT_V(0);
    if constexpr (!ALIGN_EPI) { if (wr == 0) PG8_BAR; }
    PG8_BAR;
    if constexpr (Epi::AFTER_DRAIN) { E.fused(acc, cur, wr, wc, fr, fq, lds, wid, lane); S.done(cur); }
#undef PG8_SA
#undef PG8_SB
#undef PG8_STAGE
#undef PG8_LDA
#undef PG8_LDB
#undef PG8_MMA
#undef PG8_WAIT_V
#undef PG8_WAIT_L
#undef PG8_BAR
#undef PG8_SCHED
}
}

#include <hip/hip_cooperative_groups.h>
namespace cg = cooperative_groups;
namespace mk {
using pg8::bf16_t; using pg8::bf16x8; using pg8::f32x4; using pg8::u32x4; using pg8::u32x2;
typedef float f32x16 __attribute__((ext_vector_type(16)));
#define LAS __attribute__((address_space(3)))
constexpr int NB = 4, SEQ = 8192, DM = 1024, M = NB * SEQ, INW = 2560, FF = 2816, GU = 2 * FF, DEPTH = 2;
constexpr float EPS = 1e-6f;
constexpr float QSCALE = 0.125f * 1.4426950408889634f;
constexpr size_t MiB = 1u << 20;
constexpr size_t WS_ROPE = 1 * MiB, WS_RINV = 3 * MiB, WS_SSP = 4 * MiB, WS_WSG = 6 * MiB, WS_W0 = 8 * MiB, W_LAYER = 24 * MiB;
constexpr size_t WO_IN = 0, WO_OUT = 5 * MiB, WO_GU = 7 * MiB, WO_D = 18 * MiB;
constexpr size_t WS_XN = 56 * MiB, WS_MIX = 120 * MiB, WS_U = 184 * MiB, WS_VG = 216 * MiB, WS_Q = 248 * MiB, WS_K = 280 * MiB, WS_VT = 312 * MiB, WS_Y = 344 * MiB, WS_H = 184 * MiB, WS_END = 408 * MiB;
constexpr int LDS_BYTES = 147456;
constexpr int NPHASE = 1 + 7 * DEPTH;

struct Args { const float* in[18]; float* out; unsigned char* ws; float inv_freq[32]; float lam_init[2]; int ph_lo, ph_hi; };

using pg8::shx;
__device__ __forceinline__ float wave_sum(float v, int lane) {
#pragma unroll
    for (int o = 1; o < 64; o <<= 1) v += shx(v, o, lane);
    return v;
}
__device__ __forceinline__ unsigned f2bf(float f) { unsigned u = __builtin_bit_cast(unsigned, f); return (u + 0x7fffu + ((u >> 16) & 1u)) >> 16; }
__device__ __forceinline__ unsigned pk2(float lo, float hi) { return f2bf(lo) | (f2bf(hi) << 16); }
__device__ __forceinline__ float bf2f(unsigned short b) { return __builtin_bit_cast(float, (unsigned)b << 16); }
#define LDS_WAIT() asm volatile("s_waitcnt lgkmcnt(0)" ::: "memory")

#define XB_TMO      128
#define XB_XCNT(j)  (256  + 64 * (j))
#define XB_XSUB(j)  (1280 + 64 * (j))
#define XB_XGEN(j)  (2304 + 64 * (j))
#define XB_TOP      3328
#define XB_TOPGEN   3392
#define XCD_BAR_WORDS 3456
#define XB_SPIN_CAP (1u << 18)

__device__ __forceinline__ unsigned xb_ld(unsigned* p)              { return __hip_atomic_load(p, __ATOMIC_RELAXED, __HIP_MEMORY_SCOPE_AGENT); }
__device__ __forceinline__ unsigned xb_add(unsigned* p, unsigned v) { return __hip_atomic_fetch_add(p, v, __ATOMIC_RELAXED, __HIP_MEMORY_SCOPE_AGENT); }
__device__ __forceinline__ unsigned xb_xcc_id() { return (unsigned)__builtin_amdgcn_s_getreg((3 << 11) | 20) & 0xFu; }
#define XB_SPIN(cond, bar) do { unsigned _sp = 0; while (cond) { __builtin_amdgcn_s_sleep(1); \
    if ((++_sp & 255u) == 0u) { if (xb_ld(&(bar)[XB_TMO])) break; if (_sp > XB_SPIN_CAP) { atomicAdd(&(bar)[XB_TMO], 1u); break; } } } } while (0)

struct XcdBarrier {
    unsigned* bar; unsigned x; int wid;
    volatile LAS unsigned* st;
};

#define XB_T0(w) ((w) == 0 && pg8::lane_id_opaque() == 0)
__device__ __forceinline__ XcdBarrier xcd_barrier_post(unsigned* bar, volatile LAS unsigned* st, int wid) {
    XcdBarrier b; b.bar = bar; b.x = xb_xcc_id(); b.st = st; b.wid = wid;
    if (XB_T0(wid)) (void)xb_add(&bar[XB_XCNT(b.x)], 1u);
    return b;
}
__device__ __forceinline__ void xcd_barrier_complete(unsigned* bar, unsigned x, unsigned& nloc, unsigned& nx) {
    const unsigned G = gridDim.x * gridDim.y * gridDim.z;
    unsigned sum, cnt, mine, sp = 0u;
    for (;;) {
        sum = 0u; cnt = 0u; mine = 0u;
#pragma unroll
        for (unsigned j = 0; j < 16; ++j) { const unsigned c = xb_ld(&bar[XB_XCNT(j)]); sum += c; cnt += (c > 0u) ? 1u : 0u; mine = (j == x) ? c : mine; }
        if (sum == G) break;
        __builtin_amdgcn_s_sleep(1);
        if ((++sp & 255u) == 0u) { if (xb_ld(&bar[XB_TMO])) break; if (sp > XB_SPIN_CAP) { atomicAdd(&bar[XB_TMO], 1u); break; } }
    }
    nloc = mine > 0u ? mine : 1u; nx = cnt > 0u ? cnt : 1u;
}

__device__ __forceinline__ void xcd_barrier(const XcdBarrier& b) {
    asm volatile("s_waitcnt vmcnt(0)" ::: "memory");
    __syncthreads();
    if (XB_T0(b.wid)) {
        unsigned* bar = b.bar;
        __builtin_amdgcn_s_waitcnt(0);
        unsigned nloc = b.st[0], nx = b.st[1];
        if (nloc == 0u) { xcd_barrier_complete(bar, b.x, nloc, nx); b.st[0] = nloc; b.st[1] = nx; }
        const unsigned old = xb_add(&bar[XB_XSUB(b.x)], 1u);
        const unsigned gen = old / nloc;
        if (old + 1u == (gen + 1u) * nloc) {
            __builtin_amdgcn_fence(__ATOMIC_RELEASE, "agent");
            asm volatile("s_waitcnt vmcnt(0)" ::: "memory");
            const unsigned og = xb_add(&bar[XB_TOP], 1u);
            const unsigned tg = og / nx;
            if (og + 1u == (tg + 1u) * nx) xb_add(&bar[XB_TOPGEN], 1u);
            else XB_SPIN(xb_ld(&bar[XB_TOPGEN]) == tg, bar);
            __builtin_amdgcn_fence(__ATOMIC_ACQUIRE, "agent");
            xb_add(&bar[XB_XGEN(b.x)], 1u);
            asm volatile("s_waitcnt vmcnt(0)" ::: "memory");
        } else {
            XB_SPIN(xb_ld(&bar[XB_XGEN(b.x)]) == gen, bar);
            __builtin_amdgcn_fence(__ATOMIC_ACQUIRE, "agent");
            asm volatile("s_waitcnt vmcnt(0)" ::: "memory");
        }
    }
    __syncthreads();
}


__device__ __forceinline__ void transpose_item(const float* W, int K, int N, const float* gain, bf16_t* WT, int kb, int n_dst0, int n_src0, LAS float* scr, int lane) {
    const int k0 = 64 * kb;
    float wv[32];
#pragma unroll
    for (int i = 0; i < 32; ++i) { const int kk = 2 * i + (lane >> 5); wv[i] = W[(size_t)(k0 + kk) * N + n_src0 + (lane & 31)]; }
    if (gain) {
#pragma unroll
        for (int i = 0; i < 32; ++i) wv[i] *= gain[k0 + 2 * i + (lane >> 5)];
    }
#pragma unroll
    for (int i = 0; i < 32; ++i) { const int kk = 2 * i + (lane >> 5); scr[kk * 33 + (lane & 31)] = wv[i]; }
    LDS_WAIT();
    const int c = lane & 7;
#pragma unroll
    for (int j = 0; j < 4; ++j) { const int n = (lane >> 3) + 8 * j; const LAS float* s = scr + (8 * c) * 33 + n;
        u32x4 o; o.x = pk2(s[0 * 33], s[1 * 33]); o.y = pk2(s[2 * 33], s[3 * 33]); o.z = pk2(s[4 * 33], s[5 * 33]); o.w = pk2(s[6 * 33], s[7 * 33]);
        *(u32x4*)(WT + (size_t)(n_dst0 + n) * K + k0 + 8 * c) = o; }
    LDS_WAIT();
}
__device__ __forceinline__ int win_src(int nd) {
    if (nd < 1024 || nd >= 2048) return nd;
    const int t = nd - 1024, tile = t >> 8, p = t & 255, bj = p >> 7, w = p & 127, g = w >> 5;
    return 1024 + tile * 256 + g * 64 + bj * 32;
}
__device__ __forceinline__ int wgu_src(int nd) { const int pn = nd >> 8, p = nd & 255; return p < 128 ? 128 * pn + p : FF + 128 * pn + (p - 128); }

__device__ __forceinline__ void row_to_xn(const float* xrow, bf16_t* orow, float* rinv, int lane) {
    const f32x4* xr = (const f32x4*)xrow + lane; f32x4 v[4]; float s = 0.f;
#pragma unroll
    for (int j = 0; j < 4; ++j) { v[j] = xr[64 * j]; s += (v[j][0] * v[j][0] + v[j][1] * v[j][1]) + (v[j][2] * v[j][2] + v[j][3] * v[j][3]); }
    s = wave_sum(s, lane);
    if (lane == 0) *rinv = 1.0f / sqrtf(s * (1.0f / DM) + EPS);
    u32x2* o8 = (u32x2*)orow + lane;
#pragma unroll
    for (int j = 0; j < 4; ++j) { u32x2 w; w.x = pk2(v[j][0], v[j][1]); w.y = pk2(v[j][2], v[j][3]); o8[64 * j] = w; }
}

template <int RB> __device__ __forceinline__ void res_phase(float* xout, const bf16_t* mix, const float* ssp, const float* gain, bf16_t* XN, float* rinv, int gw, int ngw, int lane) {
    f32x4 gv[4];
#pragma unroll
    for (int j = 0; j < 4; ++j) gv[j] = *((const f32x4*)gain + lane + 64 * j);
    for (int row0 = gw * RB; row0 < M; row0 += ngw * RB) {
        float ps[RB]; u32x2 xw[RB][4], mw[RB][4];
#pragma unroll
        for (int i = 0; i < RB; ++i) { const int row = row0 + i; ps[i] = ssp[(size_t)row * 16 + (lane & 15)];
            const u32x2* xr = (const u32x2*)(XN + (size_t)row * DM) + lane; const u32x2* mr = (const u32x2*)(mix + (size_t)row * DM) + lane;
#pragma unroll
            for (int j = 0; j < 4; ++j) { xw[i][j] = xr[64 * j]; mw[i][j] = mr[64 * j]; } }
#pragma unroll
        for (int i = 0; i < RB; ++i) { const int row = row0 + i; float p = ps[i];
            p += shx(p, 1, lane); p += shx(p, 2, lane); p += shx(p, 4, lane); p += shx(p, 8, lane);
            const float rm = 1.0f / sqrtf(p * (1.0f / DM) + EPS);
            f32x4 v[4]; float s = 0.f;
#pragma unroll
            for (int j = 0; j < 4; ++j) { const u32x2 a = xw[i][j], m = mw[i][j];
                f32x4 xv; xv[0] = __builtin_bit_cast(float, a.x << 16); xv[1] = __builtin_bit_cast(float, a.x & 0xffff0000u); xv[2] = __builtin_bit_cast(float, a.y << 16); xv[3] = __builtin_bit_cast(float, a.y & 0xffff0000u);
                f32x4 mv; mv[0] = __builtin_bit_cast(float, m.x << 16); mv[1] = __builtin_bit_cast(float, m.x & 0xffff0000u); mv[2] = __builtin_bit_cast(float, m.y << 16); mv[3] = __builtin_bit_cast(float, m.y & 0xffff0000u);
                v[j] = xv + mv * rm * gv[j]; s += (v[j][0] * v[j][0] + v[j][1] * v[j][1]) + (v[j][2] * v[j][2] + v[j][3] * v[j][3]); }
            if (xout) { f32x4* xo = (f32x4*)(xout + (size_t)row * DM) + lane;
#pragma unroll
                for (int j = 0; j < 4; ++j) xo[64 * j] = v[j];
            } else {
                s = wave_sum(s, lane); u32x2* xr = (u32x2*)(XN + (size_t)row * DM) + lane;
#pragma unroll
                for (int j = 0; j < 4; ++j) { u32x2 w; w.x = pk2(v[j][0], v[j][1]); w.y = pk2(v[j][2], v[j][3]); xr[64 * j] = w; }
                if (lane == 0) rinv[row] = 1.0f / sqrtf(s * (1.0f / DM) + EPS);
            } }
    }
}

__device__ __forceinline__ void gmlp_unit(LAS unsigned char* lds, const bf16_t* U, const bf16_t* VG, const bf16_t* Wg, const float* lng, const float* lnb, const float* bias, bf16_t* Y, int blk, int wid0) {
    int tid = wid0 * 64 + pg8::lane_id_opaque(); asm volatile("" : "+v"(tid));
    const int lane = tid & 63, wid = __builtin_amdgcn_readfirstlane(tid >> 6), i32 = lane & 31, hi = lane >> 5;
    const size_t tok0 = (size_t)blk * 128;
    const int g = wid >> 1, th = wid & 1;
    bf16x8 wf[2][8];
    { const bf16_t* wp = Wg + (size_t)(g * 128 + 64 * th + i32) * 128 + 8 * hi;
#pragma unroll
      for (int ti = 0; ti < 2; ++ti)
#pragma unroll
          for (int kk = 0; kk < 8; ++kk) wf[ti][kk] = *(const bf16x8*)(wp + ti * 32 * 128 + 16 * kk); }
    float lg[8], lb[8];
#pragma unroll
    for (int i = 0; i < 8; ++i) { lg[i] = lng[lane + 64 * i]; lb[i] = lnb[lane + 64 * i]; }
    for (int t8 = 0; t8 < 16; t8 += 8) {
        float v[8][8];
#pragma unroll
        for (int u = 0; u < 8; ++u) { const bf16_t* vp = VG + (tok0 + wid * 16 + t8 + u) * 512 + lane;
#pragma unroll
            for (int i = 0; i < 8; ++i) v[u][i] = bf2f(vp[64 * i]); }
#pragma unroll
        for (int u = 0; u < 8; ++u) { const int s = wid * 16 + t8 + u; float sum = 0.f;
#pragma unroll
            for (int i = 0; i < 8; ++i) sum += v[u][i];
            const float mean = wave_sum(sum, lane) * (1.0f / 512.0f); float q = 0.f;
#pragma unroll
            for (int i = 0; i < 8; ++i) { v[u][i] -= mean; q += v[u][i] * v[u][i]; }
            const float rstd = 1.0f / sqrtf(wave_sum(q, lane) * (1.0f / 512.0f) + EPS);
#pragma unroll
            for (int i = 0; i < 8; ++i) { const int c = lane + 64 * i; const float y = v[u][i] * rstd * lg[i] + lb[i];
                *(LAS bf16_t*)(lds + c * 256 + ((((s >> 3) ^ (c & 15))) << 4) + (s & 7) * 2) = (bf16_t)f2bf(y); } }
    }
    __syncthreads();
    f32x16 acc[2][4];
#pragma unroll
    for (int a = 0; a < 2; ++a)
#pragma unroll
        for (int b = 0; b < 4; ++b)
#pragma unroll
            for (int r = 0; r < 16; ++r) acc[a][b][r] = 0.f;
#pragma unroll
    for (int kk = 0; kk < 8; ++kk) {
        if (kk < 4 || th) {
#pragma unroll
            for (int ci = 0; ci < 4; ++ci) { const int c = g * 128 + 32 * ci + i32;
                const bf16x8 vfr = *(const LAS bf16x8*)(lds + c * 256 + ((((2 * kk + hi) ^ (c & 15))) << 4));
                acc[0][ci] = __builtin_amdgcn_mfma_f32_32x32x16_bf16(vfr, wf[0][kk], acc[0][ci], 0, 0, 0);
                acc[1][ci] = __builtin_amdgcn_mfma_f32_32x32x16_bf16(vfr, wf[1][kk], acc[1][ci], 0, 0, 0); } }
    }
#pragma unroll
    for (int ti = 0; ti < 2; ++ti) { const int t = 64 * th + 32 * ti + i32; const float bs = bias[g * 128 + t];
        const bf16_t* up = U + (tok0 + t) * 512 + g * 128 + 4 * hi; bf16_t* yp = Y + (tok0 + t) * 1024 + g * 128 + 4 * hi;
        u32x2 uw[4][4];
#pragma unroll
        for (int ci = 0; ci < 4; ++ci)
#pragma unroll
            for (int rq = 0; rq < 4; ++rq) uw[ci][rq] = *(const u32x2*)(up + 32 * ci + 8 * rq);
#pragma unroll
        for (int ci = 0; ci < 4; ++ci)
#pragma unroll
            for (int rq = 0; rq < 4; ++rq) { const u32x2 a = uw[ci][rq];
                const float u0 = __builtin_bit_cast(float, a.x << 16), u1 = __builtin_bit_cast(float, a.x & 0xffff0000u), u2 = __builtin_bit_cast(float, a.y << 16), u3 = __builtin_bit_cast(float, a.y & 0xffff0000u);
                u32x2 w; w.x = pk2(u0 * (acc[ti][ci][4 * rq] + bs), u1 * (acc[ti][ci][4 * rq + 1] + bs)); w.y = pk2(u2 * (acc[ti][ci][4 * rq + 2] + bs), u3 * (acc[ti][ci][4 * rq + 3] + bs));
                *(u32x2*)(yp + 32 * ci + 8 * rq) = w; }
        asm volatile("" ::: "memory");
    }
    __syncthreads();
}

__device__ __forceinline__ float fadd_s(float a, float b) { float r; asm("v_add_f32_e32 %0, %1, %2" : "=v"(r) : "v"(a), "v"(b)); return r; }
__device__ __forceinline__ float max3f(float a, float b, float c) { float r; asm("v_max3_f32 %0, %1, %2, %3" : "=v"(r) : "v"(a), "v"(b), "v"(c)); return r; }
__device__ __forceinline__ void attn_unit(LAS unsigned char* lds, const bf16_t* Q, const bf16_t* K, const bf16_t* VT, bf16_t* Y, const float* subg, float lam, float outscale, int b, int h, int qb, int wid0) {
    int tid = wid0 * 64 + pg8::lane_id_opaque(); asm volatile("" : "+v"(tid));
    const int lane = tid & 63, wid = __builtin_amdgcn_readfirstlane(tid >> 6), i32 = lane & 31, hi = lane >> 5;
    const int j = wid >> 2, wq = wid & 3;
    const size_t tok0 = (size_t)b * SEQ; const int q0 = qb * 128 + wq * 32;
    bf16x8 qf[4];
    { const bf16_t* qp = Q + (tok0 + q0 + i32) * 512 + h * 128 + j * 64 + hi * 8;
#pragma unroll
      for (int ks = 0; ks < 4; ++ks) qf[ks] = *(const bf16x8*)(qp + ks * 16); }
    f32x16 o[4];
#pragma unroll
    for (int e = 0; e < 4; ++e)
#pragma unroll
        for (int r = 0; r < 16; ++r) o[e][r] = 0.f;
    float mrun = 0.f; f32x16 negm, ol; bf16x8 ones;
#pragma unroll
    for (int r = 0; r < 16; ++r) { negm[r] = 0.f; ol[r] = 0.f; }
#pragma unroll
    for (int e = 0; e < 8; ++e) ones[e] = (short)0x3F80;
    const int ntw = 2 * qb + (wq >> 1) + 1, nta = 2 * qb + 2;
    const bf16_t* ksrc[2]; const bf16_t* vsrc[2];
#pragma unroll
    for (int i = 0; i < 2; ++i) { const int p = wid + 8 * i;
        { const int row = 4 * p + (lane >> 4), slot = lane & 15, ch = slot ^ (row & 15); ksrc[i] = K + (tok0 + row) * 512 + h * 128 + ch * 8; }
        { const int row = 8 * p + (lane >> 3), slot = lane & 7, ch = slot ^ ((row >> 1) & 7); vsrc[i] = VT + (size_t)(h * 128 + row) * M + tok0 + ch * 8; } }
#define ATT_DMA(t, s) do { _Pragma("unroll") for (int _i = 0; _i < 2; ++_i) { \
        __builtin_amdgcn_global_load_lds((const unsigned*)(ksrc[_i] + (size_t)(t) * 64 * 512), (LAS unsigned*)(lds + (s) * 32768 + (wid + 8 * _i) * 1024), 16, 0, 0); \
        __builtin_amdgcn_global_load_lds((const unsigned*)(vsrc[_i] + (size_t)(t) * 64), (LAS unsigned*)(lds + (s) * 32768 + 16384 + (wid + 8 * _i) * 1024), 16, 0, 0); } } while (0)
    const int sw = (i32 & 3) | ((i32 & 4) << 1) | ((i32 & 8) >> 1);
    const int kx = ((hi ^ sw) << 4) ^ (j << 7);
    const int kb0 = ((i32 & 16) + sw) * 256;
    const int vx = (hi ^ ((i32 >> 1) & 7)) << 4;
    const int vb0 = i32 * 128;
    ATT_DMA(0, 0); ATT_DMA(1, 1);
    if (nta > 2) { ATT_DMA(2, 2); asm volatile("s_waitcnt vmcnt(8)" ::: "memory"); } else asm volatile("s_waitcnt vmcnt(4)" ::: "memory");
    __builtin_amdgcn_s_barrier(); asm volatile("" ::: "memory");
    for (int t = 0; t < nta; ++t) {
        const int s = t & 3;
        if (t + 3 < nta) ATT_DMA(t + 3, (t + 3) & 3);
        if (t < ntw) {
            const LAS unsigned char* kb = lds + s * 32768 + kb0; const LAS unsigned char* vb = lds + s * 32768 + 16384 + vb0;
            bf16x8 kf[8];
#pragma unroll
            for (int ks = 0; ks < 4; ++ks) { const int co = kx ^ (ks << 5); kf[2 * ks] = *(const LAS bf16x8*)(kb + co); kf[2 * ks + 1] = *(const LAS bf16x8*)(kb + 8192 + co); }
            f32x16 sA, sB;
            sA = __builtin_amdgcn_mfma_f32_32x32x16_bf16(kf[0], qf[0], negm, 0, 0, 0);
            sB = __builtin_amdgcn_mfma_f32_32x32x16_bf16(kf[1], qf[0], negm, 0, 0, 0);
#pragma unroll
            for (int ks = 1; ks < 4; ++ks) {
                sA = __builtin_amdgcn_mfma_f32_32x32x16_bf16(kf[2 * ks], qf[ks], sA, 0, 0, 0);
                sB = __builtin_amdgcn_mfma_f32_32x32x16_bf16(kf[2 * ks + 1], qf[ks], sB, 0, 0, 0); }
            bf16x8 vf[16];
#pragma unroll
            for (int eb = 0; eb < 4; ++eb)
#pragma unroll
                for (int kk = 0; kk < 4; ++kk) vf[eb * 4 + kk] = *(const LAS bf16x8*)(vb + eb * 4096 + (vx ^ (kk << 5)));
            __builtin_amdgcn_sched_barrier(0);
            asm volatile("s_nop 15\n\ts_nop 7" : "+v"(sA), "+v"(sB));
            float rm = max3f(sA[0], sB[0], sA[1]), rm2 = max3f(sB[1], sA[2], sB[2]);
#pragma unroll
            for (int r = 3; r < 15; r += 2) { rm = max3f(rm, sA[r], sB[r]); rm2 = max3f(rm2, sA[r + 1], sB[r + 1]); }
            rm = max3f(rm, sA[15], sB[15]); rm = max3f(rm, rm2, rm2);
            { auto rr = __builtin_amdgcn_permlane32_swap(__builtin_bit_cast(unsigned, rm), __builtin_bit_cast(unsigned, rm), false, false);
              rm = fmaxf(__builtin_bit_cast(float, rr[0]), __builtin_bit_cast(float, rr[1])); }
            if (t == 0) {
                mrun = rm;
#pragma unroll
                for (int r = 0; r < 16; ++r) { sA[r] -= rm; sB[r] -= rm; negm[r] = -rm; }
            } else
            if (__any(rm > 8.0f)) {
                const float dl = fmaxf(rm, 0.f), al = __builtin_amdgcn_exp2f(-dl); mrun += dl;
#pragma unroll
                for (int r = 0; r < 16; ++r) ol[r] *= al;
#pragma unroll
                for (int r = 0; r < 16; ++r) { sA[r] -= dl; sB[r] -= dl; negm[r] = -mrun; }
#pragma unroll
                for (int e = 0; e < 4; ++e)
#pragma unroll
                    for (int r = 0; r < 16; ++r) o[e][r] *= al; }
#pragma unroll
            for (int r = 0; r < 16; ++r) { sA[r] = __builtin_amdgcn_exp2f(sA[r]); sB[r] = __builtin_amdgcn_exp2f(sB[r]); }
            bf16x8 P[4]; u32x4 w;
            w.x = pg8::pkbf(sA[0], sA[1]); w.y = pg8::pkbf(sA[2], sA[3]); w.z = pg8::pkbf(sA[4], sA[5]); w.w = pg8::pkbf(sA[6], sA[7]); P[0] = __builtin_bit_cast(bf16x8, w);
            w.x = pg8::pkbf(sA[8], sA[9]); w.y = pg8::pkbf(sA[10], sA[11]); w.z = pg8::pkbf(sA[12], sA[13]); w.w = pg8::pkbf(sA[14], sA[15]); P[1] = __builtin_bit_cast(bf16x8, w);
            w.x = pg8::pkbf(sB[0], sB[1]); w.y = pg8::pkbf(sB[2], sB[3]); w.z = pg8::pkbf(sB[4], sB[5]); w.w = pg8::pkbf(sB[6], sB[7]); P[2] = __builtin_bit_cast(bf16x8, w);
            w.x = pg8::pkbf(sB[8], sB[9]); w.y = pg8::pkbf(sB[10], sB[11]); w.z = pg8::pkbf(sB[12], sB[13]); w.w = pg8::pkbf(sB[14], sB[15]); P[3] = __builtin_bit_cast(bf16x8, w);
            __builtin_amdgcn_sched_barrier(0);
#pragma unroll
            for (int eb = 0; eb < 4; ++eb)
#pragma unroll
                for (int kk = 0; kk < 4; ++kk) o[eb] = __builtin_amdgcn_mfma_f32_32x32x16_bf16(vf[eb * 4 + kk], P[kk], o[eb], 0, 0, 0);
#pragma unroll
            for (int kk = 0; kk < 4; ++kk) ol = __builtin_amdgcn_mfma_f32_32x32x16_bf16(ones, P[kk], ol, 0, 0, 0);
        }
        if (t + 3 < nta) asm volatile("s_waitcnt vmcnt(8) lgkmcnt(0)" ::: "memory"); else asm volatile("s_waitcnt vmcnt(0) lgkmcnt(0)" ::: "memory");
        __builtin_amdgcn_s_barrier(); asm volatile("" ::: "memory");
    }
#undef ATT_DMA
    const float lt = ol[0];
    LAS float* xch = (LAS float*)(lds + 65536 + wq * 16384) + lane;
    if (j == 1) { const float i1 = lam / lt;
#pragma unroll
        for (int e = 0; e < 4; ++e)
#pragma unroll
            for (int r = 0; r < 16; ++r) xch[(e * 16 + r) * 64] = o[e][r] * i1; }
    __syncthreads();
    if (j == 0) { const float i0 = 1.0f / lt; float ssq = 0.f;
#pragma unroll
        for (int e = 0; e < 4; ++e)
#pragma unroll
            for (int r = 0; r < 16; ++r) { const float c = o[e][r] * i0 - xch[(e * 16 + r) * 64]; o[e][r] = c; ssq += c * c; }
        ssq += shx(ssq, 32, lane);
        const float rs = outscale / sqrtf(ssq * (1.0f / 128.0f) + EPS);
        bf16_t* yp = Y + (tok0 + q0 + i32) * 1024 + 512 + h * 128;
#pragma unroll
        for (int eb = 0; eb < 4; ++eb)
#pragma unroll
            for (int rq = 0; rq < 4; ++rq) { const int e0 = 32 * eb + 8 * rq + 4 * hi; const f32x4 gq = *(const f32x4*)(subg + e0);
                u32x2 w; w.x = pg8::pkbf(o[eb][4 * rq] * rs * gq[0], o[eb][4 * rq + 1] * rs * gq[1]); w.y = pg8::pkbf(o[eb][4 * rq + 2] * rs * gq[2], o[eb][4 * rq + 3] * rs * gq[3]);
                *(u32x2*)(yp + e0) = w; } }
    __syncthreads();
}

typedef float f32x2_t __attribute__((ext_vector_type(2))); typedef __bf16 bf16x2_t __attribute__((ext_vector_type(2)));
__device__ __forceinline__ unsigned cvtpk_c(float lo, float hi) { f32x2_t v = {lo, hi}; bf16x2_t bb = __builtin_convertvector(v, bf16x2_t); return __builtin_bit_cast(unsigned, bb); }
__device__ __forceinline__ float max3c(float x, float y, float z) { return __builtin_fmaxf(__builtin_fmaxf(x, y), z); }
__device__ __forceinline__ void attn_unit2(LAS unsigned char* lds, const bf16_t* Q, const bf16_t* K, const bf16_t* VT, bf16_t* Y, const float* subg, float lam, float outscale, int b, int h, int qb, int wid0) {
    int tid = wid0 * 64 + pg8::lane_id_opaque(); asm volatile("" : "+v"(tid));
    const int lane = tid & 63, wid = __builtin_amdgcn_readfirstlane(tid >> 6), i32 = lane & 31, hi = lane >> 5;
    const int j = wid >> 2, wq = wid & 3;
    const size_t tok0 = (size_t)b * SEQ; const int q0 = qb * 128 + wq * 32;
    bf16x8 qf[4];
    { const bf16_t* qp = Q + (tok0 + q0 + i32) * 512 + h * 128 + j * 64 + hi * 8;
#pragma unroll
      for (int ks = 0; ks < 4; ++ks) qf[ks] = *(const bf16x8*)(qp + ks * 16); }
    f32x16 o0, o1, o2, o3, negm;
#pragma unroll
    for (int r = 0; r < 16; ++r) { o0[r] = 0.f; o1[r] = 0.f; o2[r] = 0.f; o3[r] = 0.f; negm[r] = 0.f; }
    float mrun = 0.f, lsA = 0.f, lsB = 0.f, rmn = 0.f;
    const int ntw = 2 * qb + (wq >> 1) + 1, nta = 2 * qb + 2;
    const bf16_t* ksrc[2]; const bf16_t* vsrc[2];
#pragma unroll
    for (int i = 0; i < 2; ++i) { const int p = wid + 8 * i;
        { const int row = 4 * p + (lane >> 4), slot = lane & 15, ch = slot ^ (row & 15); ksrc[i] = K + (tok0 + row) * 512 + h * 128 + ch * 8; }
        { const int row = 8 * p + (lane >> 3), slot = lane & 7, ch = slot ^ ((row >> 1) & 7); vsrc[i] = VT + (size_t)(h * 128 + row) * M + tok0 + ch * 8; } }
#define ATT_DMA(t, s) do { _Pragma("unroll") for (int _i = 0; _i < 2; ++_i) { \
        __builtin_amdgcn_global_load_lds((const unsigned*)(ksrc[_i] + (size_t)(t) * 64 * 512), (LAS unsigned*)(lds + (s) * 32768 + (wid + 8 * _i) * 1024), 16, 0, 0); \
        __builtin_amdgcn_global_load_lds((const unsigned*)(vsrc[_i] + (size_t)(t) * 64), (LAS unsigned*)(lds + (s) * 32768 + 16384 + (wid + 8 * _i) * 1024), 16, 0, 0); } } while (0)
    const int sw = (i32 & 3) | ((i32 & 4) << 1) | ((i32 & 8) >> 1);
    const int kx = ((hi ^ sw) << 4) ^ (j << 7);
    const int kb0 = ((i32 & 16) + sw) * 256;
    const int vx = (hi ^ ((i32 >> 1) & 7)) << 4;
    const int vb0 = i32 * 128;
#define A2_SB() __builtin_amdgcn_sched_barrier(0)
#define A2_MF(D, A, B) D = __builtin_amdgcn_mfma_f32_32x32x16_bf16(A, B, D, 0, 0, 0)
#define A2_KLD(DA, DB, KBP, ks) do { const int co_ = kx ^ ((ks) << 5); DA = *(const LAS bf16x8*)((KBP) + co_); DB = *(const LAS bf16x8*)((KBP) + 8192 + co_); } while (0)
#define A2_VLD(D, VBP, eb, kk) D = *(const LAS bf16x8*)((VBP) + (eb) * 4096 + (vx ^ ((kk) << 5)))
#define A2_EX(X, i) do { X[i] = __builtin_amdgcn_exp2f(X[i]); X[(i) + 1] = __builtin_amdgcn_exp2f(X[(i) + 1]); lsA += X[i]; lsB += X[(i) + 1]; asm volatile("" : "+v"(lsA), "+v"(lsB)); } while (0)
#define A2_PB(k) __builtin_bit_cast(bf16x8, pw##k)
    ATT_DMA(0, 0); ATT_DMA(1, 1);
    if (nta > 2) { ATT_DMA(2, 2); asm volatile("s_waitcnt vmcnt(4)" ::: "memory"); } else asm volatile("s_waitcnt vmcnt(0)" ::: "memory");
    __builtin_amdgcn_s_barrier(); asm volatile("" ::: "memory");
    f32x16 sA, sB, nA, nB;
    {
        const LAS unsigned char* kb = lds + kb0; bf16x8 ka[4], kbq[4];
#pragma unroll
        for (int ks = 0; ks < 4; ++ks) A2_KLD(ka[ks], kbq[ks], kb, ks);
        sA = __builtin_amdgcn_mfma_f32_32x32x16_bf16(ka[0], qf[0], negm, 0, 0, 0);
        sB = __builtin_amdgcn_mfma_f32_32x32x16_bf16(kbq[0], qf[0], negm, 0, 0, 0);
#pragma unroll
        for (int ks = 1; ks < 4; ++ks) { A2_MF(sA, ka[ks], qf[ks]); A2_MF(sB, kbq[ks], qf[ks]); }
        asm volatile("s_nop 15\n\ts_nop 7" : "+v"(sA), "+v"(sB));
        float a = max3c(sA[0], sB[0], sA[1]), c = max3c(sB[1], sA[2], sB[2]);
#pragma unroll
        for (int r = 3; r < 15; r += 2) { a = max3c(a, sA[r], sB[r]); c = max3c(c, sA[r + 1], sB[r + 1]); }
        a = max3c(a, sA[15], sB[15]); rmn = max3c(a, c, c);
#pragma unroll
        for (int r = 0; r < 16; ++r) { nA[r] = 0.f; nB[r] = 0.f; }
    }
#define A2_STEP(CA, CB, NA, NB, T_) do { const int t_ = (T_); \
        if (t_ + 3 < nta) ATT_DMA(t_ + 3, (t_ + 3) & 3); \
        if (t_ < ntw) { \
            const LAS unsigned char* kbn = lds + ((t_ + 1) & 3) * 32768 + kb0; const LAS unsigned char* vbp = lds + (t_ & 3) * 32768 + 16384 + vb0; \
            bf16x8 k0a, k0b, k1a, k1b, k2a, k2b, k3a, k3b, va0, va1, va2, va3, vc0, vc1, vc2, vc3; u32x4 pw0, pw1, pw2, pw3; \
            A2_KLD(k0a, k0b, kbn, 0); A2_KLD(k1a, k1b, kbn, 1); A2_VLD(va0, vbp, 0, 0); A2_VLD(va1, vbp, 1, 0); A2_VLD(va2, vbp, 2, 0); A2_VLD(va3, vbp, 3, 0); \
            float rm = rmn; \
            { auto rr = __builtin_amdgcn_permlane32_swap(__builtin_bit_cast(unsigned, rm), __builtin_bit_cast(unsigned, rm), false, false); rm = fmaxf(__builtin_bit_cast(float, rr[0]), __builtin_bit_cast(float, rr[1])); } \
            if (t_ == 0) { mrun = rm; \
                _Pragma("unroll") for (int r = 0; r < 16; ++r) { CA[r] -= rm; CB[r] -= rm; negm[r] = -rm; } \
            } else if (__any(rm > 8.0f)) { \
                const float dl = fmaxf(rm, 0.f), al = __builtin_amdgcn_exp2f(-dl); mrun += dl; lsA *= al; lsB *= al; \
                _Pragma("unroll") for (int r = 0; r < 16; ++r) { CA[r] -= dl; CB[r] -= dl; negm[r] = -mrun; o0[r] *= al; o1[r] *= al; o2[r] *= al; o3[r] *= al; } } \
              \
            A2_EX(CA, 0); A2_EX(CA, 2); A2_EX(CA, 4); A2_EX(CA, 6); \
            pw0.x = cvtpk_c(CA[0], CA[1]); pw0.y = cvtpk_c(CA[2], CA[3]); pw0.z = cvtpk_c(CA[4], CA[5]); pw0.w = cvtpk_c(CA[6], CA[7]); A2_SB(); \
            NA = __builtin_amdgcn_mfma_f32_32x32x16_bf16(k0a, qf[0], negm, 0, 0, 0); A2_EX(CA, 8); A2_KLD(k2a, k2b, kbn, 2); A2_SB(); \
            NB = __builtin_amdgcn_mfma_f32_32x32x16_bf16(k0b, qf[0], negm, 0, 0, 0); A2_EX(CA, 10); A2_KLD(k3a, k3b, kbn, 3); A2_SB(); \
            A2_MF(NA, k1a, qf[1]); A2_EX(CA, 12); A2_SB(); \
            A2_MF(NB, k1b, qf[1]); A2_EX(CA, 14); A2_SB(); \
            A2_MF(NA, k2a, qf[2]); pw1.x = cvtpk_c(CA[8], CA[9]); pw1.y = cvtpk_c(CA[10], CA[11]); A2_VLD(vc0, vbp, 0, 1); A2_VLD(vc1, vbp, 1, 1); A2_SB(); \
            A2_MF(NB, k2b, qf[2]); pw1.z = cvtpk_c(CA[12], CA[13]); pw1.w = cvtpk_c(CA[14], CA[15]); A2_VLD(vc2, vbp, 2, 1); A2_VLD(vc3, vbp, 3, 1); A2_SB(); \
            A2_MF(NA, k3a, qf[3]); A2_EX(CB, 0); A2_SB(); \
            A2_MF(NB, k3b, qf[3]); A2_EX(CB, 2); A2_SB(); \
            A2_MF(o0, va0, A2_PB(0)); A2_EX(CB, 4); A2_SB(); \
            A2_MF(o1, va1, A2_PB(0)); A2_EX(CB, 6); A2_SB(); \
            A2_MF(o2, va2, A2_PB(0)); A2_EX(CB, 8); pw2.x = cvtpk_c(CB[0], CB[1]); pw2.y = cvtpk_c(CB[2], CB[3]); A2_SB(); \
            A2_MF(o3, va3, A2_PB(0)); A2_EX(CB, 10); pw2.z = cvtpk_c(CB[4], CB[5]); pw2.w = cvtpk_c(CB[6], CB[7]); A2_SB(); \
            A2_MF(o0, vc0, A2_PB(1)); A2_EX(CB, 12); A2_VLD(va0, vbp, 0, 2); A2_VLD(va1, vbp, 1, 2); A2_SB(); \
            A2_MF(o1, vc1, A2_PB(1)); A2_EX(CB, 14); A2_VLD(va2, vbp, 2, 2); A2_VLD(va3, vbp, 3, 2); A2_SB(); \
            A2_MF(o2, vc2, A2_PB(1)); pw3.x = cvtpk_c(CB[8], CB[9]); pw3.y = cvtpk_c(CB[10], CB[11]); A2_SB(); \
            A2_MF(o3, vc3, A2_PB(1)); pw3.z = cvtpk_c(CB[12], CB[13]); pw3.w = cvtpk_c(CB[14], CB[15]); A2_SB(); \
            float ma, mc; \
            A2_MF(o0, va0, A2_PB(2)); A2_VLD(vc0, vbp, 0, 3); A2_VLD(vc1, vbp, 1, 3); ma = max3c(NA[0], NB[0], NA[1]); mc = max3c(NB[1], NA[2], NB[2]); A2_SB(); \
            A2_MF(o1, va1, A2_PB(2)); A2_VLD(vc2, vbp, 2, 3); A2_VLD(vc3, vbp, 3, 3); ma = max3c(ma, NA[3], NB[3]); mc = max3c(mc, NA[4], NB[4]); A2_SB(); \
            A2_MF(o2, va2, A2_PB(2)); ma = max3c(ma, NA[5], NB[5]); mc = max3c(mc, NA[6], NB[6]); A2_SB(); \
            A2_MF(o3, va3, A2_PB(2)); ma = max3c(ma, NA[7], NB[7]); mc = max3c(mc, NA[8], NB[8]); A2_SB(); \
            A2_MF(o0, vc0, A2_PB(3)); ma = max3c(ma, NA[9], NB[9]); mc = max3c(mc, NA[10], NB[10]); A2_SB(); \
            A2_MF(o1, vc1, A2_PB(3)); ma = max3c(ma, NA[11], NB[11]); mc = max3c(mc, NA[12], NB[12]); A2_SB(); \
            A2_MF(o2, vc2, A2_PB(3)); ma = max3c(ma, NA[13], NB[13]); mc = max3c(mc, NA[14], NB[14]); A2_SB(); \
            A2_MF(o3, vc3, A2_PB(3)); ma = max3c(ma, NA[15], NB[15]); rmn = max3c(ma, mc, mc); A2_SB(); \
        } \
        if (t_ + 3 < nta) asm volatile("s_waitcnt vmcnt(4) lgkmcnt(0)" ::: "memory"); else asm volatile("s_waitcnt vmcnt(0) lgkmcnt(0)" ::: "memory"); \
        __builtin_amdgcn_s_barrier(); asm volatile("" ::: "memory"); } while (0)
    for (int t = 0; t < nta; t += 2) {
        A2_STEP(sA, sB, nA, nB, t);
        A2_STEP(nA, nB, sA, sB, t + 1);
    }
#undef A2_STEP
#undef A2_SB
#undef A2_MF
#undef A2_KLD
#undef A2_VLD
#undef A2_EX
#undef A2_PB
#undef ATT_DMA
    float lt = lsA + lsB; lt += shx(lt, 32, lane);
    LAS float* xch = (LAS float*)(lds + 65536 + wq * 16384) + lane;
    if (j == 1) { const float i1 = lam / lt;
#pragma unroll
        for (int r = 0; r < 16; ++r) { xch[(0 * 16 + r) * 64] = o0[r] * i1; xch[(1 * 16 + r) * 64] = o1[r] * i1; xch[(2 * 16 + r) * 64] = o2[r] * i1; xch[(3 * 16 + r) * 64] = o3[r] * i1; } }
    __syncthreads();
    if (j == 0) { const float i0 = 1.0f / lt; float ssq = 0.f;
#pragma unroll
        for (int r = 0; r < 16; ++r) { float c;
            c = o0[r] * i0 - xch[(0 * 16 + r) * 64]; o0[r] = c; ssq += c * c; c = o1[r] * i0 - xch[(1 * 16 + r) * 64]; o1[r] = c; ssq += c * c;
            c = o2[r] * i0 - xch[(2 * 16 + r) * 64]; o2[r] = c; ssq += c * c; c = o3[r] * i0 - xch[(3 * 16 + r) * 64]; o3[r] = c; ssq += c * c; }
        ssq += shx(ssq, 32, lane);
        const float rs = outscale / sqrtf(ssq * (1.0f / 128.0f) + EPS);
        bf16_t* yp = Y + (tok0 + q0 + i32) * 1024 + 512 + h * 128;
#define A2_ST(OX, eb) _Pragma("unroll") for (int rq = 0; rq < 4; ++rq) { const int e0 = 32 * (eb) + 8 * rq + 4 * hi; const f32x4 gq = *(const f32x4*)(subg + e0); \
            u32x2 w; w.x = cvtpk_c(OX[4 * rq] * rs * gq[0], OX[4 * rq + 1] * rs * gq[1]); w.y = cvtpk_c(OX[4 * rq + 2] * rs * gq[2], OX[4 * rq + 3] * rs * gq[3]); *(u32x2*)(yp + e0) = w; }
        A2_ST(o0, 0) A2_ST(o1, 1) A2_ST(o2, 2) A2_ST(o3, 3)
#undef A2_ST
    }
    __syncthreads();
}

#ifndef PROBE_GEMM_REPS
#define PROBE_GEMM_REPS 1
#endif
__global__ void __launch_bounds__(512, 2) mk_fwd(Args args) {
    extern __shared__ __attribute__((aligned(16))) unsigned char lds_raw[];
    LAS unsigned char* lds = (LAS unsigned char*)lds_raw;
    const int wid = __builtin_amdgcn_readfirstlane((int)threadIdx.x >> 6);
    const int G = gridDim.x, bx = blockIdx.x;
    const float* x = args.in[0]; float* out = args.out;
#define PHASE_PTRS() \
    unsigned char* ws = args.ws; int bxl = bx; asm volatile("" : "+s"(ws), "+s"(bxl)); int lanel = pg8::lane_id_opaque(); asm volatile("" : "+v"(lanel)); (void)lanel; \
    const int vcu = (G % 8 == 0) ? (bxl % 8) * (G / 8) + bxl / 8 : bxl; const int gw = vcu * 8 + wid, ngw = G * 8; (void)gw; (void)ngw; \
    float* rope = (float*)(ws + WS_ROPE); float* rinv = (float*)(ws + WS_RINV); float* ssp = (float*)(ws + WS_SSP); bf16_t* wsg = (bf16_t*)(ws + WS_WSG); \
    bf16_t* XN = (bf16_t*)(ws + WS_XN); bf16_t* MIX = (bf16_t*)(ws + WS_MIX); bf16_t* U = (bf16_t*)(ws + WS_U); bf16_t* VG = (bf16_t*)(ws + WS_VG); \
    bf16_t* Qb = (bf16_t*)(ws + WS_Q); bf16_t* Kb = (bf16_t*)(ws + WS_K); bf16_t* VT = (bf16_t*)(ws + WS_VT); bf16_t* Y = (bf16_t*)(ws + WS_Y); bf16_t* H = (bf16_t*)(ws + WS_H); \
    (void)rope; (void)rinv; (void)ssp; (void)wsg; (void)XN; (void)MIX; (void)U; (void)VG; (void)Qb; (void)Kb; (void)VT; (void)Y; (void)H;
    cg::grid_group grid = cg::this_grid();
    volatile LAS unsigned* misc = (volatile LAS unsigned*)(lds + 131072 + 1024);
    if (XB_T0(wid)) { misc[0] = 0u; misc[1] = 0u; }
    __syncthreads();
    XcdBarrier bar = xcd_barrier_post((unsigned*)args.ws + 4096, misc, wid);

    const int lo = args.ph_lo, hi = args.ph_hi;
#define IN(k) (lo <= (k) && (k) < hi)
#define SEAM(k) do { if (IN(k) && IN((k) + 1)) xcd_barrier(bar); } while (0)
    if (hi > NPHASE) grid.sync();
    {
        if (IN(0)) { PHASE_PTRS();
#ifndef PROBE_PRO_REPS
#define PROBE_PRO_REPS 1
#endif
            for (int rep = 0; rep < PROBE_PRO_REPS; ++rep) {
            LAS float* scr = (LAS float*)(lds + wid * 16384);
            constexpr int I_IN = 16 * 80, I_OUT = 16 * 32, I_GU = 16 * 176, I_D = 44 * 32, I_L = I_IN + I_OUT + I_GU + I_D;
            for (int it = gw; it < DEPTH * I_L; it += ngw) {
                const int l = it / I_L; int r = it % I_L; unsigned char* wl = ws + WS_W0 + (size_t)l * W_LAYER;
                if (r < I_IN) { const int kb = r / 80, nb = r % 80; transpose_item(args.in[2] + (size_t)l * DM * INW, DM, INW, args.in[1] + l * DM, (bf16_t*)(wl + WO_IN), kb, 32 * nb, win_src(32 * nb), scr, lanel); continue; } r -= I_IN;
                if (r < I_OUT) { const int kb = r / 32, nb = r % 32; transpose_item(args.in[12] + (size_t)l * DM * DM, DM, DM, nullptr, (bf16_t*)(wl + WO_OUT), kb, 32 * nb, 32 * nb, scr, lanel); continue; } r -= I_OUT;
                if (r < I_GU) { const int kb = r / 176, nb = r % 176; transpose_item(args.in[15] + (size_t)l * DM * GU, DM, GU, args.in[14] + l * DM, (bf16_t*)(wl + WO_GU), kb, 32 * nb, wgu_src(32 * nb), scr, lanel); continue; } r -= I_GU;
                { const int kb = r / 32, nb = r % 32; transpose_item(args.in[16] + (size_t)l * FF * DM, FF, DM, nullptr, (bf16_t*)(wl + WO_D), kb, 32 * nb, 32 * nb, scr, lanel); }
            }
            for (int i = gw * 64 + lanel; i < DEPTH * 4 * 128 * 128; i += ngw * 64) { const int s = i & 127, t = (i >> 7) & 127; const float w = args.in[5][i]; wsg[i] = (bf16_t)f2bf(((s >> 6) <= (t >> 6)) ? w : 0.f); }
            for (int i = gw * 64 + lanel; i < SEQ * 32; i += ngw * 64) { const int pos = i >> 5, f = i & 31; const float ang = (float)pos * args.inv_freq[f];
                double rev = (double)ang * 0.15915494309189535; rev -= floor(rev); const float rf = (float)rev;
                rope[2 * i] = __builtin_amdgcn_cosf(rf); rope[2 * i + 1] = __builtin_amdgcn_sinf(rf); }
            for (int m0 = gw * 4; m0 < M; m0 += ngw * 4) {
                f32x4 v[4][4];
#pragma unroll
                for (int i = 0; i < 4; ++i)
#pragma unroll
                    for (int jj = 0; jj < 4; ++jj) v[i][jj] = *((const f32x4*)(x + (size_t)(m0 + i) * DM) + lanel + 64 * jj);
#pragma unroll
                for (int i = 0; i < 4; ++i) { float s = 0.f; u32x2* o8 = (u32x2*)(XN + (size_t)(m0 + i) * DM) + lanel;
#pragma unroll
                    for (int jj = 0; jj < 4; ++jj) { const f32x4 t = v[i][jj]; s += (t[0] * t[0] + t[1] * t[1]) + (t[2] * t[2] + t[3] * t[3]); u32x2 w; w.x = pk2(t[0], t[1]); w.y = pk2(t[2], t[3]); o8[64 * jj] = w; }
                    s = wave_sum(s, lanel);
                    if (lanel == 0) rinv[m0 + i] = 1.0f / sqrtf(s * (1.0f / DM) + EPS); }
            }
            }
            __syncthreads();
        }
        SEAM(0);
#pragma unroll
        for (int l = 0; l < DEPTH; ++l) {
            const int p0 = 1 + 7 * l;
#define WL() unsigned char* wl = ws + WS_W0 + (size_t)l * W_LAYER
            if (IN(p0)) { PHASE_PTRS(); WL();
                { pg8::Gemm g{XN, (const bf16_t*)(wl + WO_IN), M, 2048, DM}; pg8::StaticOrder S; S.init(M, 2048, G, bxl);
                  pg8::EpiIn E{U, VG, Qb, Kb, rinv, rope, QSCALE};

#ifndef SKIP_G1A
                  for (int rep = 0; rep < PROBE_GEMM_REPS; ++rep) pg8::gemm_phase<pg8::EpiIn, pg8::StaticOrder, true, true>(lds, g, S, E, wid);
#endif
 }
                { pg8::Gemm g{(const bf16_t*)(wl + WO_IN) + (size_t)2048 * DM, XN, 512, M, DM}; pg8::StaticOrder S; S.init(512, M, G, bxl);
                  pg8::EpiVT E{VT, M, rinv};

#ifndef SKIP_G1B
                  for (int rep = 0; rep < PROBE_GEMM_REPS; ++rep) pg8::gemm_phase<pg8::EpiVT, pg8::StaticOrder, true, true>(lds, g, S, E, wid);
#endif
 }
            }
            SEAM(p0);
            if (IN(p0 + 1)) { PHASE_PTRS();
                const float lam0 = args.lam_init[l];
                const float a = wave_sum(args.in[7][l * 64 + lanel] * args.in[8][l * 64 + lanel], lanel), bq = wave_sum(args.in[9][l * 64 + lanel] * args.in[10][l * 64 + lanel], lanel);
                const float lam = __builtin_bit_cast(float, __builtin_amdgcn_readfirstlane(__builtin_bit_cast(int, expf(a) - expf(bq) + lam0)));
#ifndef PROBE_ATTN_REPS
#define PROBE_ATTN_REPS 1
#endif
                for (int rep = 0; rep < PROBE_ATTN_REPS; ++rep)
                for (int p = vcu; p < 256; p += G) {
                    const int xcd = p >> 5, c = p & 31;
#ifndef SKIP_ATTN
#pragma unroll 1
                    for (int i = 0; i < 4; ++i) { const int bh = 2 * xcd + (i >> 1), qb = (i & 1) ? c : 63 - c;
                        attn_unit2(lds, Qb, Kb, VT, Y, args.in[11] + l * 128, lam, 1.0f - lam0, bh >> 2, bh & 3, qb, wid); }
#endif
                }
#ifndef SKIP_GMLP
#ifndef PROBE_GMLP_REPS
#define PROBE_GMLP_REPS 1
#endif
                for (int rep = 0; rep < PROBE_GMLP_REPS; ++rep)
                for (int blk = vcu; blk < M / 128; blk += G)
                    gmlp_unit(lds, U, VG, wsg + (size_t)l * 4 * 128 * 128, args.in[3] + l * 512, args.in[4] + l * 512, args.in[6] + l * 512, Y, blk, wid);
#endif
            }
            SEAM(p0 + 1);
            if (IN(p0 + 2)) { PHASE_PTRS(); WL();
                pg8::Gemm g{Y, (const bf16_t*)(wl + WO_OUT), M, DM, DM}; pg8::StaticOrder S; S.init(M, DM, G, bxl);
                pg8::EpiSS E{MIX, ssp};

#ifndef SKIP_G2
                  for (int rep = 0; rep < PROBE_GEMM_REPS; ++rep) pg8::gemm_phase<pg8::EpiSS, pg8::StaticOrder, true, true>(lds, g, S, E, wid);
#endif

            }
            SEAM(p0 + 2);
            if (IN(p0 + 3)) { PHASE_PTRS();
                res_phase<8>(nullptr, MIX, ssp, args.in[13] + l * DM, XN, rinv, gw, ngw, lanel);
            }
            SEAM(p0 + 3);
            if (IN(p0 + 4)) { PHASE_PTRS(); WL();
                pg8::Gemm g{XN, (const bf16_t*)(wl + WO_GU), M, GU, DM}; pg8::StaticOrder S; S.init(M, GU, G, bxl);
                pg8::EpiGU E{H, FF, rinv};

#ifndef SKIP_G3
                  for (int rep = 0; rep < PROBE_GEMM_REPS; ++rep) pg8::gemm_phase<pg8::EpiGU, pg8::StaticOrder, true, true>(lds, g, S, E, wid);
#endif

            }
            SEAM(p0 + 4);
            if (IN(p0 + 5)) { PHASE_PTRS(); WL();
                pg8::Gemm g{H, (const bf16_t*)(wl + WO_D), M, DM, FF}; pg8::StaticOrder S; S.init(M, DM, G, bxl);
                pg8::EpiSS E{MIX, ssp};

#ifndef SKIP_G2
                  for (int rep = 0; rep < PROBE_GEMM_REPS; ++rep) pg8::gemm_phase<pg8::EpiSS, pg8::StaticOrder, true, true>(lds, g, S, E, wid);
#endif

            }
            SEAM(p0 + 5);
            if (IN(p0 + 6)) { PHASE_PTRS();
                res_phase<8>(l == DEPTH - 1 ? out : nullptr, MIX, ssp, args.in[17] + l * DM, XN, rinv, gw, ngw, lanel);
            }
            SEAM(p0 + 6);
        }
    }
#undef IN
#undef SEAM
#undef PHASE_PTRS
#undef WL
}
}

#ifndef MK_MULTI
#define MK_MULTI 0
#endif
extern "C" void kernel_launch(void* const* d_in, const int* in_sizes, int n_in, void* d_out, int out_size, void* d_ws, size_t ws_size, hipStream_t stream) {
    using namespace mk;
    static int grid = 0;
    if (grid == 0) {
        if (n_in != 18 || out_size != M * DM || ws_size < WS_END) { fprintf(stderr, "kernel_launch: unexpected problem (n_in %d out %d ws %zu)\n", n_in, out_size, ws_size); grid = -1; return; }
        int dev = 0, cus = 0, per_cu = 0;
        hipGetDevice(&dev); hipDeviceGetAttribute(&cus, hipDeviceAttributeMultiprocessorCount, dev);
        if (hipFuncSetAttribute((const void*)mk_fwd, hipFuncAttributeMaxDynamicSharedMemorySize, LDS_BYTES) != hipSuccess) { fprintf(stderr, "kernel_launch: hipFuncSetAttribute failed\n"); grid = -1; return; }
        hipOccupancyMaxActiveBlocksPerMultiprocessor(&per_cu, (const void*)mk_fwd, 512, LDS_BYTES);
        if (per_cu < 1) { fprintf(stderr, "kernel_launch: occupancy query says %d blocks/CU\n", per_cu); per_cu = 1; }
        (void)hipGetLastError();
        grid = cus;
    }
    if (grid < 0) return;
    if (hipMemsetAsync(d_ws, 0, 65536, stream) != hipSuccess) { fprintf(stderr, "kernel_launch: hipMemsetAsync failed\n"); return; }
    Args a{};
    for (int i = 0; i < 18; ++i) a.in[i] = (const float*)d_in[i];
    a.out = (float*)d_out; a.ws = (unsigned char*)d_ws;
    for (int i = 0; i < 32; ++i) a.inv_freq[i] = 1.0f / powf(10000.0f, (float)(2 * i) / 64.0f);
    for (int l = 0; l < 2; ++l) a.lam_init[l] = (float)(0.8 - 0.6 * exp(-0.3 * (double)l));
#if MK_MULTI
    for (int ph = 0; ph < NPHASE; ++ph) { a.ph_lo = ph; a.ph_hi = ph + 1; hipLaunchKernelGGL(mk_fwd, dim3(grid), dim3(512), LDS_BYTES, stream, a); }
#else
    a.ph_lo = 0; a.ph_hi = NPHASE;
    void* kargs[] = {&a};
    hipError_t e = hipLaunchCooperativeKernel((const void*)mk_fwd, dim3(grid), dim3(512), kargs, LDS_BYTES, stream);
    if (e != hipSuccess) fprintf(stderr, "cooperative launch failed: %s (grid %d)\n", hipGetErrorString(e), grid);
#endif
}
```

```cpp
#include <hip/hip_runtime.h>
#include <cstdio>
#include <cstdint>
#include <cmath>
namespace pg8 {
#define PG8_LAS __attribute__((address_space(3)))
typedef unsigned short bf16_t;
typedef short bf16x8 __attribute__((ext_vector_type(8)));
typedef float f32x4 __attribute__((ext_vector_type(4)));
typedef unsigned u32x4 __attribute__((ext_vector_type(4)));
constexpr int BM = 256, BK = 64, HALF = 128, HTB = HALF * BK * 2  , STAGE_BYTES = 8 * HTB, NXCD = 8, WGM = 4;

__host__ __device__ __forceinline__ int lds_byte(int r, int c) { const int st = (r >> 4) * 2 + (c >> 5), rr = r & 15, cc = c & 31, ob = rr * 64 + cc * 2; return st * 1024 + (ob ^ (((ob >> 9) & 1) << 5)); }
__host__ __device__ __forceinline__ void stage_rc(int b, int& R, int& C) { const int st = b / 1024, sb = b % 1024, swz = sb ^ (((sb >> 9) & 1) << 5); R = (st >> 1) * 16 + swz / 64; C = (st & 1) * 32 + (swz % 64) / 2; }
__host__ __device__ __forceinline__ int perm32(int rho) { const int n = rho >> 4, i = rho & 15; return 8 * (i >> 2) + 4 * n + (i & 3); }

struct Unit { int pm, pn; };
struct Gemm { const bf16_t* A; const bf16_t* Bt; int M, N, K; };

struct StaticOrder {
    int nM, nN, nwg, G, c;
    __host__ __device__ void init(int M, int N, int G_, int c_) { nM = M / BM; nN = N / BM; nwg = nM * nN; G = G_; c = c_; }
    __host__ __device__ bool next(int i, Unit& u) const {
        const long L = (long)i * G + c; if (L >= nwg) return false;
        int wgid = (int)L; { const int q = nwg / NXCD, r = nwg % NXCD, xcd = wgid % NXCD, off = wgid / NXCD; wgid = (xcd < r ? xcd * (q + 1) : r * (q + 1) + (xcd - r) * q) + off; }
        const int nig = WGM * nN, gid = wgid / nig, fm = gid * WGM, gsz = (nM - fm) < WGM ? (nM - fm) : WGM;
        u.pm = fm + ((wgid % nig) % gsz); u.pn = (wgid % nig) / gsz; return true;
    }
    __device__ __forceinline__ void a_ready(const Unit&) const {}
    __device__ __forceinline__ void done(const Unit&) const {}
};

__device__ __forceinline__ unsigned cvt_pk_bf16(float lo, float hi) { unsigned r; asm volatile("v_cvt_pk_bf16_f32 %0, %1, %2" : "=v"(r) : "v"(lo), "v"(hi)); return r; }
typedef float f32x2 __attribute__((ext_vector_type(2)));
__device__ __forceinline__ f32x2 gelu_pk(f32x2 v) {
    const f32x2 av = __builtin_elementwise_abs(v), d = av * 0.2316418882f + 1.0f;
    f32x2 t; t.x = __builtin_amdgcn_rcpf(d.x); t.y = __builtin_amdgcn_rcpf(d.y);
    f32x2 q = t * 0.5307027145f + (-0.7265760135f); q = q * t + 0.7107068705f; q = q * t + (-0.142248368f); q = q * t + 0.127414796f; q = q * t;
    const f32x2 s = (v * v) * (-0.72134752044f);
    f32x2 e; e.x = __builtin_amdgcn_exp2f(s.x); e.y = __builtin_amdgcn_exp2f(s.y);
    const f32x2 m = v * (q * e), r = v - m;
    f32x2 o; o.x = v.x < 0.f ? m.x : r.x; o.y = v.y < 0.f ? m.y : r.y; return o;
}


typedef unsigned u32x2 __attribute__((ext_vector_type(2)));
__device__ __forceinline__ float shx(float v, int m, int lane) { return __builtin_bit_cast(float, __builtin_amdgcn_ds_bpermute((lane ^ m) << 2, __builtin_bit_cast(int, v))); }
__device__ __forceinline__ unsigned pkbf(float lo, float hi) { unsigned r; asm("v_cvt_pk_bf16_f32 %0, %1, %2" : "=v"(r) : "v"(lo), "v"(hi)); return r; }
__device__ __forceinline__ u32x4 pack8(f32x4 a, f32x4 b) { u32x4 w; w.x = pkbf(a[0], a[1]); w.y = pkbf(a[2], a[3]); w.z = pkbf(b[0], b[1]); w.w = pkbf(b[2], b[3]); return w; }

struct EpiIn {
    static constexpr bool PERM = true, AFTER_DRAIN = false;
    bf16_t *U, *VG, *Q, *K; const float* rinv; const float* rope  ; float qscale;
    __device__ __forceinline__ void operator()(const f32x4 (&acc)[2][2][4][2], const Unit& u, int wr, int wc, int fr, int fq) const {
        const int sec = u.pn >> 1, half = u.pn & 1;
        const int row0 = u.pm * BM + wr * 64 + fr;
        if (sec < 2) {
            bf16_t* base = (sec == 0 ? U : VG) + half * 256 + wc * 32 + 8 * fq;
#pragma unroll
            for (int ai = 0; ai < 2; ++ai)
#pragma unroll
                for (int m = 0; m < 4; ++m) { const int row = row0 + ai * HALF + m * 16; const float rs = rinv[row]; bf16_t* rowp = base + (size_t)row * 512;
#pragma unroll
                    for (int bj = 0; bj < 2; ++bj) { f32x4 v0 = acc[ai][bj][m][0] * rs, v1 = acc[ai][bj][m][1] * rs;
                        f32x2 a = gelu_pk((f32x2){v0[0], v0[1]}), b = gelu_pk((f32x2){v0[2], v0[3]}), c = gelu_pk((f32x2){v1[0], v1[1]}), d = gelu_pk((f32x2){v1[2], v1[3]});
                        u32x4 w; w.x = pkbf(a.x, a.y); w.y = pkbf(b.x, b.y); w.z = pkbf(c.x, c.y); w.w = pkbf(d.x, d.y);
                        *(u32x4*)(rowp + bj * HALF) = w; } }
        } else {
            bf16_t* base = (sec == 2 ? Q : K) + half * 256 + wc * 64 + 8 * fq;
            const float sc = (sec == 2) ? qscale : 1.f;
#pragma unroll
            for (int ai = 0; ai < 2; ++ai)
#pragma unroll
                for (int m = 0; m < 4; ++m) { const int row = row0 + ai * HALF + m * 16; const float rs = rinv[row] * sc; bf16_t* rowp = base + (size_t)row * 512;
                    const f32x4* rp = (const f32x4*)(rope + ((size_t)(row & 8191) * 32 + 8 * fq) * 2);
                    const f32x4 r0 = rp[0], r1 = rp[1], r2 = rp[2], r3 = rp[3];
                    const f32x4 x1a = acc[ai][0][m][0] * rs, x1b = acc[ai][0][m][1] * rs, x2a = acc[ai][1][m][0] * rs, x2b = acc[ai][1][m][1] * rs;
                    f32x4 o1a, o1b, o2a, o2b;
                    o1a[0] = x1a[0] * r0[0] - x2a[0] * r0[1]; o2a[0] = x2a[0] * r0[0] + x1a[0] * r0[1];
                    o1a[1] = x1a[1] * r0[2] - x2a[1] * r0[3]; o2a[1] = x2a[1] * r0[2] + x1a[1] * r0[3];
                    o1a[2] = x1a[2] * r1[0] - x2a[2] * r1[1]; o2a[2] = x2a[2] * r1[0] + x1a[2] * r1[1];
                    o1a[3] = x1a[3] * r1[2] - x2a[3] * r1[3]; o2a[3] = x2a[3] * r1[2] + x1a[3] * r1[3];
                    o1b[0] = x1b[0] * r2[0] - x2b[0] * r2[1]; o2b[0] = x2b[0] * r2[0] + x1b[0] * r2[1];
                    o1b[1] = x1b[1] * r2[2] - x2b[1] * r2[3]; o2b[1] = x2b[1] * r2[2] + x1b[1] * r2[3];
                    o1b[2] = x1b[2] * r3[0] - x2b[2] * r3[1]; o2b[2] = x2b[2] * r3[0] + x1b[2] * r3[1];
                    o1b[3] = x1b[3] * r3[2] - x2b[3] * r3[3]; o2b[3] = x2b[3] * r3[2] + x1b[3] * r3[3];
                    *(u32x4*)(rowp) = pack8(o1a, o1b); *(u32x4*)(rowp + 32) = pack8(o2a, o2b); }
        }
    }
};
struct EpiVT {
    static constexpr bool PERM = true, AFTER_DRAIN = false;
    bf16_t* VT; int ldc; const float* rinv;
    __device__ __forceinline__ void operator()(const f32x4 (&acc)[2][2][4][2], const Unit& u, int wr, int wc, int fr, int fq) const {
        const int row0 = u.pm * BM + wr * 64 + fr, col0 = u.pn * BM + wc * 32 + 8 * fq;
        f32x4 rv[2][2];
#pragma unroll
        for (int bj = 0; bj < 2; ++bj)
#pragma unroll
            for (int n = 0; n < 2; ++n) rv[bj][n] = *(const f32x4*)(rinv + col0 + bj * HALF + 4 * n);
#pragma unroll
        for (int ai = 0; ai < 2; ++ai)
#pragma unroll
            for (int m = 0; m < 4; ++m) { bf16_t* rowp = VT + (size_t)(row0 + ai * HALF + m * 16) * ldc + col0;
#pragma unroll
                for (int bj = 0; bj < 2; ++bj) *(u32x4*)(rowp + bj * HALF) = pack8(acc[ai][bj][m][0] * rv[bj][0], acc[ai][bj][m][1] * rv[bj][1]); }
    }
};
struct EpiSS {
    static constexpr bool PERM = true, AFTER_DRAIN = false;
    bf16_t* O; float* ssp;
    __device__ __forceinline__ void operator()(const f32x4 (&acc)[2][2][4][2], const Unit& u, int wr, int wc, int fr, int fq) const {
        asm volatile("s_nop 15\n\ts_nop 7" ::: "memory");
        const int row0 = u.pm * BM + wr * 64 + fr, col0 = u.pn * BM + wc * 32 + 8 * fq;
#pragma unroll
        for (int ai = 0; ai < 2; ++ai)
#pragma unroll
            for (int m = 0; m < 4; ++m) { const int row = row0 + ai * HALF + m * 16; bf16_t* rowp = O + (size_t)row * 1024 + col0; float s = 0.f;
#pragma unroll
                for (int bj = 0; bj < 2; ++bj) { const f32x4 v0 = acc[ai][bj][m][0], v1 = acc[ai][bj][m][1];
                    s += (v0[0] * v0[0] + v0[1] * v0[1]) + (v0[2] * v0[2] + v0[3] * v0[3]) + (v1[0] * v1[0] + v1[1] * v1[1]) + (v1[2] * v1[2] + v1[3] * v1[3]);
                    *(u32x4*)(rowp + bj * HALF) = pack8(v0, v1); }
                { const int ln = fq * 16 + fr; s += shx(s, 16, ln); s += shx(s, 32, ln); }
                if (fq == 0) ssp[(size_t)row * 16 + u.pn * 4 + wc] = s; }
    }
};
struct EpiGU {
    static constexpr bool PERM = true, AFTER_DRAIN = false;
    bf16_t* H; int ldc; const float* rinv;
    __device__ __forceinline__ void operator()(const f32x4 (&acc)[2][2][4][2], const Unit& u, int wr, int wc, int fr, int fq) const {
        const int row0 = u.pm * BM + wr * 64 + fr, col0 = u.pn * HALF + wc * 32 + 8 * fq;
#pragma unroll
        for (int ai = 0; ai < 2; ++ai)
#pragma unroll
            for (int m = 0; m < 4; ++m) { const int row = row0 + ai * HALF + m * 16; const float rs = rinv[row]; f32x4 h[2];
#pragma unroll
                for (int n = 0; n < 2; ++n) { const f32x4 g = acc[ai][0][m][n] * rs, up = acc[ai][1][m][n] * rs;
#pragma unroll
                    for (int e = 0; e < 4; ++e) { const float ex = __builtin_amdgcn_exp2f(g[e] * -1.4426950408889634f); h[n][e] = g[e] * __builtin_amdgcn_rcpf(1.0f + ex) * up[e]; } }
                __builtin_nontemporal_store(pack8(h[0], h[1]), (u32x4*)(H + (size_t)row * ldc + col0)); }
    }
};
__device__ __forceinline__ int lane_id_opaque() { unsigned z = 0u; asm volatile("" : "+v"(z)); return (int)__builtin_amdgcn_mbcnt_hi(~0u, __builtin_amdgcn_mbcnt_lo(~0u, z)); }
template <class Epi, class Sched, bool ALIGN_EPI = false, bool SP2 = false>
__device__ __forceinline__ void gemm_phase(PG8_LAS unsigned char* lds, const Gemm g, const Sched& S, const Epi& E, int wid0) {
    int tid = wid0 * 64 + lane_id_opaque(); asm volatile("" : "+v"(tid));
    const int wid = __builtin_amdgcn_readfirstlane(tid >> 6), lane = tid & 63, wr = wid >> 2, wc = wid & 3, fr = lane & 15, fq = lane >> 4;
    const int K = g.K, nt = K / BK;
    unsigned voffA[2], voffB[2];
#pragma unroll
    for (int i = 0; i < 2; ++i) { int R, C; stage_rc(tid * 16 + i * 8192, R, C); const int Rb = Epi::PERM ? ((R & ~31) + perm32(R & 31)) : R;
        voffA[i] = (unsigned)(R * K + C) * 2u; voffB[i] = (unsigned)(Rb * K + C) * 2u; }
    const size_t kstep = (size_t)(BK * 2);
    const size_t hstep = (size_t)HALF * K * 2;
    const size_t tstep = 2 * hstep;
    const unsigned ldsw = (unsigned)wid * 1024u;
    const int aoff = lds_byte(wr * 64 + fr, fq * 8), boff = lds_byte(wc * 32 + fr, fq * 8);
#define PG8_SA(b, h) (((b) * 2 + (h)) * HTB)
#define PG8_SB(b, h) ((4 + (b) * 2 + (h)) * HTB)
#define PG8_STAGE(bufoff, gbase, voff) do { _Pragma("unroll") for (int _i = 0; _i < 2; ++_i) \
        __builtin_amdgcn_global_load_lds((const unsigned*)((const char*)(gbase) + (voff)[_i]), (PG8_LAS unsigned*)(lds + (bufoff) + ldsw + _i * 8192), 16, 0, 0); } while (0)
#define PG8_LDA(dst, b, h) do { _Pragma("unroll") for (int m = 0; m < 4; ++m) _Pragma("unroll") for (int k = 0; k < 2; ++k) dst[m][k] = *(const PG8_LAS bf16x8*)(lds + PG8_SA(b, h) + aoff + m * 2048 + k * 1024); } while (0)
#define PG8_LDB(dst, b, h) do { _Pragma("unroll") for (int n = 0; n < 2; ++n) _Pragma("unroll") for (int k = 0; k < 2; ++k) dst[n][k] = *(const PG8_LAS bf16x8*)(lds + PG8_SB(b, h) + boff + n * 2048 + k * 1024); } while (0)
#define PG8_MMA(ai, bj, At, Bt) do { __builtin_amdgcn_s_setprio(1); _Pragma("unroll") for (int m = 0; m < 4; ++m) _Pragma("unroll") for (int n = 0; n < 2; ++n) _Pragma("unroll") for (int k = 0; k < 2; ++k) \
        acc[ai][bj][m][n] = __builtin_amdgcn_mfma_f32_16x16x32_bf16(Bt[n][k], At[m][k], acc[ai][bj][m][n], 0, 0, 0); __builtin_amdgcn_s_setprio(0); } while (0)
#define PG8_WAIT_V(n) asm volatile("s_waitcnt vmcnt(" #n ")" ::: "memory")
#define PG8_WAIT_L(n) asm volatile("s_waitcnt lgkmcnt(" #n ")" ::: "memory")
#define PG8_BAR __builtin_amdgcn_s_barrier()
#define PG8_SCHED __builtin_amdgcn_sched_barrier(0)
    Unit cur, nxt; int ui = 0;
    if (!S.next(0, cur)) return;
    f32x4 acc[2][2][4][2];
#pragma unroll
    for (int a = 0; a < 2; ++a)
#pragma unroll
        for (int b = 0; b < 2; ++b)
#pragma unroll
            for (int m = 0; m < 4; ++m)
#pragma unroll
                for (int n = 0; n < 2; ++n) acc[a][b][m][n] = (f32x4){0.f, 0.f, 0.f, 0.f};
    bf16x8 At[4][2], B0[2][2], B1[2][2];
    const char* cA = (const char*)g.A + (size_t)cur.pm * tstep; const char* cB = (const char*)g.Bt + (size_t)cur.pn * tstep;
    S.a_ready(cur);
    if constexpr (SP2) {
        PG8_STAGE(PG8_SB(0, 0), cB, voffB); PG8_STAGE(PG8_SB(0, 1), cB + hstep, voffB); PG8_STAGE(PG8_SA(0, 0), cA, voffA); PG8_STAGE(PG8_SA(0, 1), cA + hstep, voffA);
        if (wr == 1) PG8_BAR;
        PG8_WAIT_V(2); PG8_BAR;
        PG8_STAGE(PG8_SB(1, 0), cB + kstep, voffB); PG8_STAGE(PG8_SA(1, 0), cA + kstep, voffA); PG8_STAGE(PG8_SB(1, 1), cB + hstep + kstep, voffB);
        PG8_WAIT_V(6); PG8_BAR;
    } else {
        PG8_STAGE(PG8_SB(0, 0), cB, voffB); PG8_STAGE(PG8_SA(0, 0), cA, voffA); PG8_STAGE(PG8_SB(0, 1), cB + hstep, voffB); PG8_STAGE(PG8_SA(0, 1), cA + hstep, voffA);
        if (wr == 1) PG8_BAR;
        PG8_WAIT_V(4); PG8_BAR;
        PG8_STAGE(PG8_SB(1, 0), cB + kstep, voffB); PG8_STAGE(PG8_SA(1, 0), cA + kstep, voffA); PG8_STAGE(PG8_SB(1, 1), cB + hstep + kstep, voffB);
        PG8_WAIT_V(6); PG8_BAR;
    }
    for (;;) {
        const bool has_next = S.next(ui + 1, nxt);
        const char* nA = has_next ? (const char*)g.A + (size_t)nxt.pm * tstep : cA; const char* nB = has_next ? (const char*)g.Bt + (size_t)nxt.pn * tstep : cB;
        for (int t = 0; t < nt; t += 2) {
            const bool last = (t == nt - 2);
            const char* a1 = cA + (size_t)(t + 1) * kstep;
            const char* a2 = last ? nA : cA + (size_t)(t + 2) * kstep; const char* b2 = last ? nB : cB + (size_t)(t + 2) * kstep;
            const char* a3 = a2 + kstep; const char* b3 = b2 + kstep;
            if (last && has_next) S.a_ready(nxt);
            if constexpr (SP2) {
            PG8_LDB(B0, 0, 0); PG8_LDB(B1, 0, 1); PG8_SCHED; PG8_LDA(At, 0, 0); PG8_STAGE(PG8_SA(1, 1), a1 + hstep, voffA);
            PG8_WAIT_V(8); PG8_WAIT_L(0); PG8_BAR; PG8_MMA(0, 0, At, B0); PG8_MMA(0, 1, At, B1); PG8_BAR; PG8_SCHED;
            PG8_LDA(At, 0, 1); PG8_STAGE(PG8_SB(0, 0), b2, voffB); PG8_STAGE(PG8_SB(0, 1), b2 + hstep, voffB); PG8_STAGE(PG8_SA(0, 0), a2, voffA);
            PG8_WAIT_V(8); PG8_WAIT_L(0); PG8_BAR; PG8_MMA(1, 0, At, B0); PG8_MMA(1, 1, At, B1); PG8_BAR; PG8_SCHED;
            PG8_LDB(B0, 1, 0); PG8_LDB(B1, 1, 1); PG8_SCHED; PG8_LDA(At, 1, 0); PG8_STAGE(PG8_SA(0, 1), a2 + hstep, voffA);
            PG8_WAIT_V(8); PG8_WAIT_L(0); PG8_BAR; PG8_MMA(0, 0, At, B0); PG8_MMA(0, 1, At, B1); PG8_BAR; PG8_SCHED;
            PG8_LDA(At, 1, 1); PG8_STAGE(PG8_SB(1, 0), b3, voffB); PG8_STAGE(PG8_SB(1, 1), b3 + hstep, voffB); PG8_STAGE(PG8_SA(1, 0), a3, voffA);
            PG8_WAIT_V(8); PG8_WAIT_L(0); PG8_BAR; PG8_MMA(1, 0, At, B0); PG8_MMA(1, 1, At, B1); PG8_BAR; PG8_SCHED;
            } else {
            PG8_LDB(B0, 0, 0); PG8_SCHED; PG8_LDA(At, 0, 0); PG8_STAGE(PG8_SA(1, 1), a1 + hstep, voffA);
            PG8_WAIT_L(8); PG8_BAR; PG8_WAIT_L(0); PG8_MMA(0, 0, At, B0); PG8_BAR; PG8_SCHED;
            PG8_LDB(B1, 0, 1); PG8_STAGE(PG8_SB(0, 0), b2, voffB);
            PG8_BAR; PG8_WAIT_L(0); PG8_MMA(0, 1, At, B1); PG8_BAR;
            PG8_LDA(At, 0, 1); PG8_STAGE(PG8_SA(0, 0), a2, voffA);
            PG8_BAR; PG8_WAIT_L(0); PG8_MMA(1, 0, At, B0); PG8_BAR; PG8_SCHED;
            PG8_STAGE(PG8_SB(0, 1), b2 + hstep, voffB);
            PG8_WAIT_V(6); PG8_BAR; PG8_MMA(1, 1, At, B1); PG8_BAR;
            PG8_LDB(B0, 1, 0); PG8_SCHED; PG8_LDA(At, 1, 0); PG8_STAGE(PG8_SA(0, 1), a2 + hstep, voffA);
            PG8_WAIT_L(8); PG8_BAR; PG8_WAIT_L(0); PG8_MMA(0, 0, At, B0); PG8_BAR; PG8_SCHED;
            PG8_LDB(B1, 1, 1); PG8_STAGE(PG8_SB(1, 0), b3, voffB);
            PG8_BAR; PG8_WAIT_L(0); PG8_MMA(0, 1, At, B1); PG8_BAR;
            PG8_LDA(At, 1, 1); PG8_STAGE(PG8_SA(1, 0), a3, voffA);
            PG8_BAR; PG8_WAIT_L(0); PG8_MMA(1, 0, At, B0); PG8_BAR; PG8_SCHED;
            PG8_STAGE(PG8_SB(1, 1), b3 + hstep, voffB);
            PG8_WAIT_V(6); PG8_BAR; PG8_MMA(1, 1, At, B1); PG8_BAR;
            }
        }
        if constexpr (ALIGN_EPI) { if (wr == 0) PG8_BAR; }
        if constexpr (!Epi::AFTER_DRAIN) { E(acc, cur, wr, wc, fr, fq); S.done(cur); }
        if (!has_next) break;
#pragma unroll
        for (int a = 0; a < 2; ++a)
#pragma unroll
            for (int b = 0; b < 2; ++b)
#pragma unroll
                for (int m = 0; m < 4; ++m)
#pragma unroll
                    for (int n = 0; n < 2; ++n) acc[a][b][m][n] = (f32x4){0.f, 0.f, 0.f, 0.f};
        cur = nxt; cA = nA; cB = nB; ++ui;
        if constexpr (ALIGN_EPI) { if (wr == 1) PG8_BAR; }
    }
    PG8_WAIT_V(0);
    if constexpr (!ALIGN_EPI) { if (wr == 0) PG8_BAR; }
    PG8_BAR;
    if constexpr (Epi::AFTER_DRAIN) { E.fused(acc, cur, wr, wc, fr, fq, lds, wid, lane); S.done(cur); }
#undef PG8_SA
#undef PG8_SB
#undef PG8_STAGE
#undef PG8_LDA
#undef PG8_LDB
#undef PG8_MMA
#undef PG8_WAIT_V
#undef PG8_WAIT_L
#undef PG8_BAR
#undef PG8_SCHED
}
}

#include <hip/hip_cooperative_groups.h>
namespace cg = cooperative_groups;
namespace mk {
using pg8::bf16_t; using pg8::bf16x8; using pg8::f32x4; using pg8::u32x4; using pg8::u32x2;
typedef float f32x16 __attribute__((ext_vector_type(16)));
#define LAS __attribute__((address_space(3)))
constexpr int NB = 4, SEQ = 8192, DM = 1024, M = NB * SEQ, INW = 2560, FF = 2816, GU = 2 * FF, DEPTH = 2;
constexpr float EPS = 1e-6f;
constexpr float QSCALE = 0.125f * 1.4426950408889634f;
constexpr size_t MiB = 1u << 20;
constexpr size_t WS_ROPE = 1 * MiB, WS_RINV = 3 * MiB, WS_SSP = 4 * MiB, WS_WSG = 6 * MiB, WS_W0 = 8 * MiB, W_LAYER = 24 * MiB;
constexpr size_t WO_IN = 0, WO_OUT = 5 * MiB, WO_GU = 7 * MiB, WO_D = 18 * MiB;
constexpr size_t WS_XN = 56 * MiB, WS_MIX = 120 * MiB, WS_U = 184 * MiB, WS_VG = 216 * MiB, WS_Q = 248 * MiB, WS_K = 280 * MiB, WS_VT = 312 * MiB, WS_Y = 344 * MiB, WS_H = 184 * MiB, WS_END = 408 * MiB;
constexpr int LDS_BYTES = 147456;
constexpr int NPHASE = 1 + 7 * DEPTH;

struct Args { const float* in[18]; float* out; unsigned char* ws; float inv_freq[32]; float lam_init[2]; int ph_lo, ph_hi; };

using pg8::shx;
__device__ __forceinline__ float wave_sum(float v, int lane) {
#pragma unroll
    for (int o = 1; o < 64; o <<= 1) v += shx(v, o, lane);
    return v;
}
__device__ __forceinline__ unsigned f2bf(float f) { unsigned u = __builtin_bit_cast(unsigned, f); return (u + 0x7fffu + ((u >> 16) & 1u)) >> 16; }
__device__ __forceinline__ unsigned pk2(float lo, float hi) { return f2bf(lo) | (f2bf(hi) << 16); }
__device__ __forceinline__ float bf2f(unsigned short b) { return __builtin_bit_cast(float, (unsigned)b << 16); }
#define LDS_WAIT() asm volatile("s_waitcnt lgkmcnt(0)" ::: "memory")

#define XB_TMO      128
#define XB_XCNT(j)  (256  + 64 * (j))
#define XB_XSUB(j)  (1280 + 64 * (j))
#define XB_XGEN(j)  (2304 + 64 * (j))
#define XB_TOP      3328
#define XB_TOPGEN   3392
#define XCD_BAR_WORDS 3456
#define XB_SPIN_CAP (1u << 18)

__device__ __forceinline__ unsigned xb_ld(unsigned* p)              { return __hip_atomic_load(p, __ATOMIC_RELAXED, __HIP_MEMORY_SCOPE_AGENT); }
__device__ __forceinline__ unsigned xb_add(unsigned* p, unsigned v) { return __hip_atomic_fetch_add(p, v, __ATOMIC_RELAXED, __HIP_MEMORY_SCOPE_AGENT); }
__device__ __forceinline__ unsigned xb_xcc_id() { return (unsigned)__builtin_amdgcn_s_getreg((3 << 11) | 20) & 0xFu; }
#define XB_SPIN(cond, bar) do { unsigned _sp = 0; while (cond) { __builtin_amdgcn_s_sleep(1); \
    if ((++_sp & 255u) == 0u) { if (xb_ld(&(bar)[XB_TMO])) break; if (_sp > XB_SPIN_CAP) { atomicAdd(&(bar)[XB_TMO], 1u); break; } } } } while (0)

struct XcdBarrier {
    unsigned* bar; unsigned x; int wid;
    volatile LAS unsigned* st;
};

#define XB_T0(w) ((w) == 0 && pg8::lane_id_opaque() == 0)
__device__ __forceinline__ XcdBarrier xcd_barrier_post(unsigned* bar, volatile LAS unsigned* st, int wid) {
    XcdBarrier b; b.bar = bar; b.x = xb_xcc_id(); b.st = st; b.wid = wid;
    if (XB_T0(wid)) (void)xb_add(&bar[XB_XCNT(b.x)], 1u);
    return b;
}
__device__ __forceinline__ void xcd_barrier_complete(unsigned* bar, unsigned x, unsigned& nloc, unsigned& nx) {
    const unsigned G = gridDim.x * gridDim.y * gridDim.z;
    unsigned sum, cnt, mine, sp = 0u;
    for (;;) {
        sum = 0u; cnt = 0u; mine = 0u;
#pragma unroll
        for (unsigned j = 0; j < 16; ++j) { const unsigned c = xb_ld(&bar[XB_XCNT(j)]); sum += c; cnt += (c > 0u) ? 1u : 0u; mine = (j == x) ? c : mine; }
        if (sum == G) break;
        __builtin_amdgcn_s_sleep(1);
        if ((++sp & 255u) == 0u) { if (xb_ld(&bar[XB_TMO])) break; if (sp > XB_SPIN_CAP) { atomicAdd(&bar[XB_TMO], 1u); break; } }
    }
    nloc = mine > 0u ? mine : 1u; nx = cnt > 0u ? cnt : 1u;
}

__device__ __forceinline__ void xcd_barrier(const XcdBarrier& b) {
    asm volatile("s_waitcnt vmcnt(0)" ::: "memory");
    __syncthreads();
    if (XB_T0(b.wid)) {
        unsigned* bar = b.bar;
        __builtin_amdgcn_s_waitcnt(0);
        unsigned nloc = b.st[0], nx = b.st[1];
        if (nloc == 0u) { xcd_barrier_complete(bar, b.x, nloc, nx); b.st[0] = nloc; b.st[1] = nx; }
        const unsigned old = xb_add(&bar[XB_XSUB(b.x)], 1u);
        const unsigned gen = old / nloc;
        if (old + 1u == (gen + 1u) * nloc) {
            __builtin_amdgcn_fence(__ATOMIC_RELEASE, "agent");
            asm volatile("s_waitcnt vmcnt(0)" ::: "memory");
            const unsigned og = xb_add(&bar[XB_TOP], 1u);
            const unsigned tg = og / nx;
            if (og + 1u == (tg + 1u) * nx) xb_add(&bar[XB_TOPGEN], 1u);
            else XB_SPIN(xb_ld(&bar[XB_TOPGEN]) == tg, bar);
            __builtin_amdgcn_fence(__ATOMIC_ACQUIRE, "agent");
            xb_add(&bar[XB_XGEN(b.x)], 1u);
            asm volatile("s_waitcnt vmcnt(0)" ::: "memory");
        } else {
            XB_SPIN(xb_ld(&bar[XB_XGEN(b.x)]) == gen, bar);
            __builtin_amdgcn_fence(__ATOMIC_ACQUIRE, "agent");
            asm volatile("s_waitcnt vmcnt(0)" ::: "memory");
        }
    }
    __syncthreads();
}


__device__ __forceinline__ void transpose_item(const float* W, int K, int N, const float* gain, bf16_t* WT, int kb, int n_dst0, int n_src0, LAS float* scr, int lane) {
    const int k0 = 64 * kb;
    float wv[32];
#pragma unroll
    for (int i = 0; i < 32; ++i) { const int kk = 2 * i + (lane >> 5); wv[i] = W[(size_t)(k0 + kk) * N + n_src0 + (lane & 31)]; }
    if (gain) {
#pragma unroll
        for (int i = 0; i < 32; ++i) wv[i] *= gain[k0 + 2 * i + (lane >> 5)];
    }
#pragma unroll
    for (int i = 0; i < 32; ++i) { const int kk = 2 * i + (lane >> 5); scr[kk * 33 + (lane & 31)] = wv[i]; }
    LDS_WAIT();
    const int c = lane & 7;
#pragma unroll
    for (int j = 0; j < 4; ++j) { const int n = (lane >> 3) + 8 * j; const LAS float* s = scr + (8 * c) * 33 + n;
        u32x4 o; o.x = pk2(s[0 * 33], s[1 * 33]); o.y = pk2(s[2 * 33], s[3 * 33]); o.z = pk2(s[4 * 33], s[5 * 33]); o.w = pk2(s[6 * 33], s[7 * 33]);
        *(u32x4*)(WT + (size_t)(n_dst0 + n) * K + k0 + 8 * c) = o; }
    LDS_WAIT();
}
__device__ __forceinline__ int win_src(int nd) {
    if (nd < 1024 || nd >= 2048) return nd;
    const int t = nd - 1024, tile = t >> 8, p = t & 255, bj = p >> 7, w = p & 127, g = w >> 5;
    return 1024 + tile * 256 + g * 64 + bj * 32;
}
__device__ __forceinline__ int wgu_src(int nd) { const int pn = nd >> 8, p = nd & 255; return p < 128 ? 128 * pn + p : FF + 128 * pn + (p - 128); }

__device__ __forceinline__ void row_to_xn(const float* xrow, bf16_t* orow, float* rinv, int lane) {
    const f32x4* xr = (const f32x4*)xrow + lane; f32x4 v[4]; float s = 0.f;
#pragma unroll
    for (int j = 0; j < 4; ++j) { v[j] = xr[64 * j]; s += (v[j][0] * v[j][0] + v[j][1] * v[j][1]) + (v[j][2] * v[j][2] + v[j][3] * v[j][3]); }
    s = wave_sum(s, lane);
    if (lane == 0) *rinv = 1.0f / sqrtf(s * (1.0f / DM) + EPS);
    u32x2* o8 = (u32x2*)orow + lane;
#pragma unroll
    for (int j = 0; j < 4; ++j) { u32x2 w; w.x = pk2(v[j][0], v[j][1]); w.y = pk2(v[j][2], v[j][3]); o8[64 * j] = w; }
}

template <int RB> __device__ __forceinline__ void res_phase(float* xout, const bf16_t* mix, const float* ssp, const float* gain, bf16_t* XN, float* rinv, int gw, int ngw, int lane) {
    f32x4 gv[4];
#pragma unroll
    for (int j = 0; j < 4; ++j) gv[j] = *((const f32x4*)gain + lane + 64 * j);
    for (int row0 = gw * RB; row0 < M; row0 += ngw * RB) {
        float ps[RB]; u32x2 xw[RB][4], mw[RB][4];
#pragma unroll
        for (int i = 0; i < RB; ++i) { const int row = row0 + i; ps[i] = ssp[(size_t)row * 16 + (lane & 15)];
            const u32x2* xr = (const u32x2*)(XN + (size_t)row * DM) + lane; const u32x2* mr = (const u32x2*)(mix + (size_t)row * DM) + lane;
#pragma unroll
            for (int j = 0; j < 4; ++j) { xw[i][j] = xr[64 * j]; mw[i][j] = mr[64 * j]; } }
#pragma unroll
        for (int i = 0; i < RB; ++i) { const int row = row0 + i; float p = ps[i];
            p += shx(p, 1, lane); p += shx(p, 2, lane); p += shx(p, 4, lane); p += shx(p, 8, lane);
            const float rm = 1.0f / sqrtf(p * (1.0f / DM) + EPS);
            f32x4 v[4]; float s = 0.f;
#pragma unroll
            for (int j = 0; j < 4; ++j) { const u32x2 a = xw[i][j], m = mw[i][j];
                f32x4 xv; xv[0] = __builtin_bit_cast(float, a.x << 16); xv[1] = __builtin_bit_cast(float, a.x & 0xffff0000u); xv[2] = __builtin_bit_cast(float, a.y << 16); xv[3] = __builtin_bit_cast(float, a.y & 0xffff0000u);
                f32x4 mv; mv[0] = __builtin_bit_cast(float, m.x << 16); mv[1] = __builtin_bit_cast(float, m.x & 0xffff0000u); mv[2] = __builtin_bit_cast(float, m.y << 16); mv[3] = __builtin_bit_cast(float, m.y & 0xffff0000u);
                v[j] = xv + mv * rm * gv[j]; s += (v[j][0] * v[j][0] + v[j][1] * v[j][1]) + (v[j][2] * v[j][2] + v[j][3] * v[j][3]); }
            if (xout) { f32x4* xo = (f32x4*)(xout + (size_t)row * DM) + lane;
#pragma unroll
                for (int j = 0; j < 4; ++j) xo[64 * j] = v[j];
            } else {
                s = wave_sum(s, lane); u32x2* xr = (u32x2*)(XN + (size_t)row * DM) + lane;
#pragma unroll
                for (int j = 0; j < 4; ++j) { u32x2 w; w.x = pk2(v[j][0], v[j][1]); w.y = pk2(v[j][2], v[j][3]); xr[64 * j] = w; }
                if (lane == 0) rinv[row] = 1.0f / sqrtf(s * (1.0f / DM) + EPS);
            } }
    }
}

__device__ __forceinline__ void gmlp_unit(LAS unsigned char* lds, const bf16_t* U, const bf16_t* VG, const bf16_t* Wg, const float* lng, const float* lnb, const float* bias, bf16_t* Y, int blk, int wid0) {
    int tid = wid0 * 64 + pg8::lane_id_opaque(); asm volatile("" : "+v"(tid));
    const int lane = tid & 63, wid = __builtin_amdgcn_readfirstlane(tid >> 6), i32 = lane & 31, hi = lane >> 5;
    const size_t tok0 = (size_t)blk * 128;
    const int g = wid >> 1, th = wid & 1;
    bf16x8 wf[2][8];
    { const bf16_t* wp = Wg + (size_t)(g * 128 + 64 * th + i32) * 128 + 8 * hi;
#pragma unroll
      for (int ti = 0; ti < 2; ++ti)
#pragma unroll
          for (int kk = 0; kk < 8; ++kk) wf[ti][kk] = *(const bf16x8*)(wp + ti * 32 * 128 + 16 * kk); }
    float lg[8], lb[8];
#pragma unroll
    for (int i = 0; i < 8; ++i) { lg[i] = lng[lane + 64 * i]; lb[i] = lnb[lane + 64 * i]; }
    for (int t8 = 0; t8 < 16; t8 += 8) {
        float v[8][8];
#pragma unroll
        for (int u = 0; u < 8; ++u) { const bf16_t* vp = VG + (tok0 + wid * 16 + t8 + u) * 512 + lane;
#pragma unroll
            for (int i = 0; i < 8; ++i) v[u][i] = bf2f(vp[64 * i]); }
#pragma unroll
        for (int u = 0; u < 8; ++u) { const int s = wid * 16 + t8 + u; float sum = 0.f;
#pragma unroll
            for (int i = 0; i < 8; ++i) sum += v[u][i];
            const float mean = wave_sum(sum, lane) * (1.0f / 512.0f); float q = 0.f;
#pragma unroll
            for (int i = 0; i < 8; ++i) { v[u][i] -= mean; q += v[u][i] * v[u][i]; }
            const float rstd = 1.0f / sqrtf(wave_sum(q, lane) * (1.0f / 512.0f) + EPS);
#pragma unroll
            for (int i = 0; i < 8; ++i) { const int c = lane + 64 * i; const float y = v[u][i] * rstd * lg[i] + lb[i];
                *(LAS bf16_t*)(lds + c * 256 + ((((s >> 3) ^ (c & 15))) << 4) + (s & 7) * 2) = (bf16_t)f2bf(y); } }
    }
    __syncthreads();
    f32x16 acc[2][4];
#pragma unroll
    for (int a = 0; a < 2; ++a)
#pragma unroll
        for (int b = 0; b < 4; ++b)
#pragma unroll
            for (int r = 0; r < 16; ++r) acc[a][b][r] = 0.f;
#pragma unroll
    for (int kk = 0; kk < 8; ++kk) {
        if (kk < 4 || th) {
#pragma unroll
            for (int ci = 0; ci < 4; ++ci) { const int c = g * 128 + 32 * ci + i32;
                const bf16x8 vfr = *(const LAS bf16x8*)(lds + c * 256 + ((((2 * kk + hi) ^ (c & 15))) << 4));
                acc[0][ci] = __builtin_amdgcn_mfma_f32_32x32x16_bf16(vfr, wf[0][kk], acc[0][ci], 0, 0, 0);
                acc[1][ci] = __builtin_amdgcn_mfma_f32_32x32x16_bf16(vfr, wf[1][kk], acc[1][ci], 0, 0, 0); } }
    }
#pragma unroll
    for (int ti = 0; ti < 2; ++ti) { const int t = 64 * th + 32 * ti + i32; const float bs = bias[g * 128 + t];
        const bf16_t* up = U + (tok0 + t) * 512 + g * 128 + 4 * hi; bf16_t* yp = Y + (tok0 + t) * 1024 + g * 128 + 4 * hi;
        u32x2 uw[4][4];
#pragma unroll
        for (int ci = 0; ci < 4; ++ci)
#pragma unroll
            for (int rq = 0; rq < 4; ++rq) uw[ci][rq] = *(const u32x2*)(up + 32 * ci + 8 * rq);
#pragma unroll
        for (int ci = 0; ci < 4; ++ci)
#pragma unroll
            for (int rq = 0; rq < 4; ++rq) { const u32x2 a = uw[ci][rq];
                const float u0 = __builtin_bit_cast(float, a.x << 16), u1 = __builtin_bit_cast(float, a.x & 0xffff0000u), u2 = __builtin_bit_cast(float, a.y << 16), u3 = __builtin_bit_cast(float, a.y & 0xffff0000u);
                u32x2 w; w.x = pk2(u0 * (acc[ti][ci][4 * rq] + bs), u1 * (acc[ti][ci][4 * rq + 1] + bs)); w.y = pk2(u2 * (acc[ti][ci][4 * rq + 2] + bs), u3 * (acc[ti][ci][4 * rq + 3] + bs));
                *(u32x2*)(yp + 32 * ci + 8 * rq) = w; }
        asm volatile("" ::: "memory");
    }
    __syncthreads();
}

__device__ __forceinline__ float fadd_s(float a, float b) { float r; asm("v_add_f32_e32 %0, %1, %2" : "=v"(r) : "v"(a), "v"(b)); return r; }
__device__ __forceinline__ float max3f(float a, float b, float c) { float r; asm("v_max3_f32 %0, %1, %2, %3" : "=v"(r) : "v"(a), "v"(b), "v"(c)); return r; }
__device__ __forceinline__ void attn_unit(LAS unsigned char* lds, const bf16_t* Q, const bf16_t* K, const bf16_t* VT, bf16_t* Y, const float* subg, float lam, float outscale, int b, int h, int qb, int wid0) {
    int tid = wid0 * 64 + pg8::lane_id_opaque(); asm volatile("" : "+v"(tid));
    const int lane = tid & 63, wid = __builtin_amdgcn_readfirstlane(tid >> 6), i32 = lane & 31, hi = lane >> 5;
    const int j = wid >> 2, wq = wid & 3;
    const size_t tok0 = (size_t)b * SEQ; const int q0 = qb * 128 + wq * 32;
    bf16x8 qf[4];
    { const bf16_t* qp = Q + (tok0 + q0 + i32) * 512 + h * 128 + j * 64 + hi * 8;
#pragma unroll
      for (int ks = 0; ks < 4; ++ks) qf[ks] = *(const bf16x8*)(qp + ks * 16); }
    f32x16 o[4];
#pragma unroll
    for (int e = 0; e < 4; ++e)
#pragma unroll
        for (int r = 0; r < 16; ++r) o[e][r] = 0.f;
    float mrun = 0.f; f32x16 negm, ol; bf16x8 ones;
#pragma unroll
    for (int r = 0; r < 16; ++r) { negm[r] = 0.f; ol[r] = 0.f; }
#pragma unroll
    for (int e = 0; e < 8; ++e) ones[e] = (short)0x3F80;
    const int ntw = 2 * qb + (wq >> 1) + 1, nta = 2 * qb + 2;
    const bf16_t* ksrc[2]; const bf16_t* vsrc[2];
#pragma unroll
    for (int i = 0; i < 2; ++i) { const int p = wid + 8 * i;
        { const int row = 4 * p + (lane >> 4), slot = lane & 15, ch = slot ^ (row & 15); ksrc[i] = K + (tok0 + row) * 512 + h * 128 + ch * 8; }
        { const int row = 8 * p + (lane >> 3), slot = lane & 7, ch = slot ^ ((row >> 1) & 7); vsrc[i] = VT + (size_t)(h * 128 + row) * M + tok0 + ch * 8; } }
#define ATT_DMA(t, s) do { _Pragma("unroll") for (int _i = 0; _i < 2; ++_i) { \
        __builtin_amdgcn_global_load_lds((const unsigned*)(ksrc[_i] + (size_t)(t) * 64 * 512), (LAS unsigned*)(lds + (s) * 32768 + (wid + 8 * _i) * 1024), 16, 0, 0); \
        __builtin_amdgcn_global_load_lds((const unsigned*)(vsrc[_i] + (size_t)(t) * 64), (LAS unsigned*)(lds + (s) * 32768 + 16384 + (wid + 8 * _i) * 1024), 16, 0, 0); } } while (0)
    const int sw = (i32 & 3) | ((i32 & 4) << 1) | ((i32 & 8) >> 1);
    const int kx = ((hi ^ sw) << 4) ^ (j << 7);
    const int kb0 = ((i32 & 16) + sw) * 256;
    const int vx = (hi ^ ((i32 >> 1) & 7)) << 4;
    const int vb0 = i32 * 128;
    ATT_DMA(0, 0); ATT_DMA(1, 1);
    if (nta > 2) { ATT_DMA(2, 2); asm volatile("s_waitcnt vmcnt(8)" ::: "memory"); } else asm volatile("s_waitcnt vmcnt(4)" ::: "memory");
    __builtin_amdgcn_s_barrier(); asm volatile("" ::: "memory");
    for (int t = 0; t < nta; ++t) {
        const int s = t & 3;
        if (t + 3 < nta) ATT_DMA(t + 3, (t + 3) & 3);
        if (t < ntw) {
            const LAS unsigned char* kb = lds + s * 32768 + kb0; const LAS unsigned char* vb = lds + s * 32768 + 16384 + vb0;
            bf16x8 kf[8];
#pragma unroll
            for (int ks = 0; ks < 4; ++ks) { const int co = kx ^ (ks << 5); kf[2 * ks] = *(const LAS bf16x8*)(kb + co); kf[2 * ks + 1] = *(const LAS bf16x8*)(kb + 8192 + co); }
            f32x16 sA, sB;
            sA = __builtin_amdgcn_mfma_f32_32x32x16_bf16(kf[0], qf[0], negm, 0, 0, 0);
            sB = __builtin_amdgcn_mfma_f32_32x32x16_bf16(kf[1], qf[0], negm, 0, 0, 0);
#pragma unroll
            for (int ks = 1; ks < 4; ++ks) {
                sA = __builtin_amdgcn_mfma_f32_32x32x16_bf16(kf[2 * ks], qf[ks], sA, 0, 0, 0);
                sB = __builtin_amdgcn_mfma_f32_32x32x16_bf16(kf[2 * ks + 1], qf[ks], sB, 0, 0, 0); }
            bf16x8 vf[16];
#pragma unroll
            for (int eb = 0; eb < 4; ++eb)
#pragma unroll
                for (int kk = 0; kk < 4; ++kk) vf[eb * 4 + kk] = *(const LAS bf16x8*)(vb + eb * 4096 + (vx ^ (kk << 5)));
            __builtin_amdgcn_sched_barrier(0);
            asm volatile("s_nop 15\n\ts_nop 7" : "+v"(sA), "+v"(sB));
            float rm = max3f(sA[0], sB[0], sA[1]), rm2 = max3f(sB[1], sA[2], sB[2]);
#pragma unroll
            for (int r = 3; r < 15; r += 2) { rm = max3f(rm, sA[r], sB[r]); rm2 = max3f(rm2, sA[r + 1], sB[r + 1]); }
            rm = max3f(rm, sA[15], sB[15]); rm = max3f(rm, rm2, rm2);
            { auto rr = __builtin_amdgcn_permlane32_swap(__builtin_bit_cast(unsigned, rm), __builtin_bit_cast(unsigned, rm), false, false);
              rm = fmaxf(__builtin_bit_cast(float, rr[0]), __builtin_bit_cast(float, rr[1])); }
            if (t == 0) {
                mrun = rm;
#pragma unroll
                for (int r = 0; r < 16; ++r) { sA[r] -= rm; sB[r] -= rm; negm[r] = -rm; }
            } else
            if (__any(rm > 8.0f)) {
                const float dl = fmaxf(rm, 0.f), al = __builtin_amdgcn_exp2f(-dl); mrun += dl;
#pragma unroll
                for (int r = 0; r < 16; ++r) ol[r] *= al;
#pragma unroll
                for (int r = 0; r < 16; ++r) { sA[r] -= dl; sB[r] -= dl; negm[r] = -mrun; }
#pragma unroll
                for (int e = 0; e < 4; ++e)
#pragma unroll
                    for (int r = 0; r < 16; ++r) o[e][r] *= al; }
#pragma unroll
            for (int r = 0; r < 16; ++r) { sA[r] = __builtin_amdgcn_exp2f(sA[r]); sB[r] = __builtin_amdgcn_exp2f(sB[r]); }
            bf16x8 P[4]; u32x4 w;
            w.x = pg8::pkbf(sA[0], sA[1]); w.y = pg8::pkbf(sA[2], sA[3]); w.z = pg8::pkbf(sA[4], sA[5]); w.w = pg8::pkbf(sA[6], sA[7]); P[0] = __builtin_bit_cast(bf16x8, w);
            w.x = pg8::pkbf(sA[8], sA[9]); w.y = pg8::pkbf(sA[10], sA[11]); w.z = pg8::pkbf(sA[12], sA[13]); w.w = pg8::pkbf(sA[14], sA[15]); P[1] = __builtin_bit_cast(bf16x8, w);
            w.x = pg8::pkbf(sB[0], sB[1]); w.y = pg8::pkbf(sB[2], sB[3]); w.z = pg8::pkbf(sB[4], sB[5]); w.w = pg8::pkbf(sB[6], sB[7]); P[2] = __builtin_bit_cast(bf16x8, w);
            w.x = pg8::pkbf(sB[8], sB[9]); w.y = pg8::pkbf(sB[10], sB[11]); w.z = pg8::pkbf(sB[12], sB[13]); w.w = pg8::pkbf(sB[14], sB[15]); P[3] = __builtin_bit_cast(bf16x8, w);
            __builtin_amdgcn_sched_barrier(0);
#pragma unroll
            for (int eb = 0; eb < 4; ++eb)
#pragma unroll
                for (int kk = 0; kk < 4; ++kk) o[eb] = __builtin_amdgcn_mfma_f32_32x32x16_bf16(vf[eb * 4 + kk], P[kk], o[eb], 0, 0, 0);
#pragma unroll
            for (int kk = 0; kk < 4; ++kk) ol = __builtin_amdgcn_mfma_f32_32x32x16_bf16(ones, P[kk], ol, 0, 0, 0);
        }
        if (t + 3 < nta) asm volatile("s_waitcnt vmcnt(8) lgkmcnt(0)" ::: "memory"); else asm volatile("s_waitcnt vmcnt(0) lgkmcnt(0)" ::: "memory");
        __builtin_amdgcn_s_barrier(); asm volatile("" ::: "memory");
    }
#undef ATT_DMA
    const float lt = ol[0];
    LAS float* xch = (LAS float*)(lds + 65536 + wq * 16384) + lane;
    if (j == 1) { const float i1 = lam / lt;
#pragma unroll
        for (int e = 0; e < 4; ++e)
#pragma unroll
            for (int r = 0; r < 16; ++r) xch[(e * 16 + r) * 64] = o[e][r] * i1; }
    __syncthreads();
    if (j == 0) { const float i0 = 1.0f / lt; float ssq = 0.f;
#pragma unroll
        for (int e = 0; e < 4; ++e)
#pragma unroll
            for (int r = 0; r < 16; ++r) { const float c = o[e][r] * i0 - xch[(e * 16 + r) * 64]; o[e][r] = c; ssq += c * c; }
        ssq += shx(ssq, 32, lane);
        const float rs = outscale / sqrtf(ssq * (1.0f / 128.0f) + EPS);
        bf16_t* yp = Y + (tok0 + q0 + i32) * 1024 + 512 + h * 128;
#pragma unroll
        for (int eb = 0; eb < 4; ++eb)
#pragma unroll
            for (int rq = 0; rq < 4; ++rq) { const int e0 = 32 * eb + 8 * rq + 4 * hi; const f32x4 gq = *(const f32x4*)(subg + e0);
                u32x2 w; w.x = pg8::pkbf(o[eb][4 * rq] * rs * gq[0], o[eb][4 * rq + 1] * rs * gq[1]); w.y = pg8::pkbf(o[eb][4 * rq + 2] * rs * gq[2], o[eb][4 * rq + 3] * rs * gq[3]);
                *(u32x2*)(yp + e0) = w; } }
    __syncthreads();
}

typedef float f32x2_t __attribute__((ext_vector_type(2))); typedef __bf16 bf16x2_t __attribute__((ext_vector_type(2)));
__device__ __forceinline__ unsigned cvtpk_c(float lo, float hi) { f32x2_t v = {lo, hi}; bf16x2_t bb = __builtin_convertvector(v, bf16x2_t); return __builtin_bit_cast(unsigned, bb); }
__device__ __forceinline__ float max3c(float x, float y, float z) { return __builtin_fmaxf(__builtin_fmaxf(x, y), z); }
__device__ __forceinline__ void attn_unit2(LAS unsigned char* lds, const bf16_t* Q, const bf16_t* K, const bf16_t* VT, bf16_t* Y, const float* subg, float lam, float outscale, int b, int h, int qb, int wid0) {
    int tid = wid0 * 64 + pg8::lane_id_opaque(); asm volatile("" : "+v"(tid));
    const int lane = tid & 63, wid = __builtin_amdgcn_readfirstlane(tid >> 6), i32 = lane & 31, hi = lane >> 5;
    const int j = wid >> 2, wq = wid & 3;
    const size_t tok0 = (size_t)b * SEQ; const int q0 = qb * 128 + wq * 32;
    bf16x8 qf[4];
    { const bf16_t* qp = Q + (tok0 + q0 + i32) * 512 + h * 128 + j * 64 + hi * 8;
#pragma unroll
      for (int ks = 0; ks < 4; ++ks) qf[ks] = *(const bf16x8*)(qp + ks * 16); }
    f32x16 o0, o1, o2, o3, negm;
#pragma unroll
    for (int r = 0; r < 16; ++r) { o0[r] = 0.f; o1[r] = 0.f; o2[r] = 0.f; o3[r] = 0.f; negm[r] = 0.f; }
    float mrun = 0.f, lsA = 0.f, lsB = 0.f, rmn = 0.f;
    const int ntw = 2 * qb + (wq >> 1) + 1, nta = 2 * qb + 2;
    const bf16_t* ksrc[2]; const bf16_t* vsrc[2];
#pragma unroll
    for (int i = 0; i < 2; ++i) { const int p = wid + 8 * i;
        { const int row = 4 * p + (lane >> 4), slot = lane & 15, ch = slot ^ (row & 15); ksrc[i] = K + (tok0 + row) * 512 + h * 128 + ch * 8; }
        { const int row = 8 * p + (lane >> 3), slot = lane & 7, ch = slot ^ ((row >> 1) & 7); vsrc[i] = VT + (size_t)(h * 128 + row) * M + tok0 + ch * 8; } }
#define ATT_DMA(t, s) do { _Pragma("unroll") for (int _i = 0; _i < 2; ++_i) { \
        __builtin_amdgcn_global_load_lds((const unsigned*)(ksrc[_i] + (size_t)(t) * 64 * 512), (LAS unsigned*)(lds + (s) * 32768 + (wid + 8 * _i) * 1024), 16, 0, 0); \
        __builtin_amdgcn_global_load_lds((const unsigned*)(vsrc[_i] + (size_t)(t) * 64), (LAS unsigned*)(lds + (s) * 32768 + 16384 + (wid + 8 * _i) * 1024), 16, 0, 0); } } while (0)
    const int sw = (i32 & 3) | ((i32 & 4) << 1) | ((i32 & 8) >> 1);
    const int kx = ((hi ^ sw) << 4) ^ (j << 7);
    const int kb0 = ((i32 & 16) + sw) * 256;
    const int vx = (hi ^ ((i32 >> 1) & 7)) << 4;
    const int vb0 = i32 * 128;
#define A2_SB() __builtin_amdgcn_sched_barrier(0)
#define A2_MF(D, A, B) D = __builtin_amdgcn_mfma_f32_32x32x16_bf16(A, B, D, 0, 0, 0)
#define A2_KLD(DA, DB, KBP, ks) do { const int co_ = kx ^ ((ks) << 5); DA = *(const LAS bf16x8*)((KBP) + co_); DB = *(const LAS bf16x8*)((KBP) + 8192 + co_); } while (0)
#define A2_VLD(D, VBP, eb, kk) D = *(const LAS bf16x8*)((VBP) + (eb) * 4096 + (vx ^ ((kk) << 5)))
#define A2_EX(X, i) do { X[i] = __builtin_amdgcn_exp2f(X[i]); X[(i) + 1] = __builtin_amdgcn_exp2f(X[(i) + 1]); lsA += X[i]; lsB += X[(i) + 1]; asm volatile("" : "+v"(lsA), "+v"(lsB)); } while (0)
#define A2_PB(k) __builtin_bit_cast(bf16x8, pw##k)
    ATT_DMA(0, 0); ATT_DMA(1, 1);
    if (nta > 2) { ATT_DMA(2, 2); asm volatile("s_waitcnt vmcnt(4)" ::: "memory"); } else asm volatile("s_waitcnt vmcnt(0)" ::: "memory");
    __builtin_amdgcn_s_barrier(); asm volatile("" ::: "memory");
    f32x16 sA, sB, nA, nB;
    {
        const LAS unsigned char* kb = lds + kb0; bf16x8 ka[4], kbq[4];
#pragma unroll
        for (int ks = 0; ks < 4; ++ks) A2_KLD(ka[ks], kbq[ks], kb, ks);
        sA = __builtin_amdgcn_mfma_f32_32x32x16_bf16(ka[0], qf[0], negm, 0, 0, 0);
        sB = __builtin_amdgcn_mfma_f32_32x32x16_bf16(kbq[0], qf[0], negm, 0, 0, 0);
#pragma unroll
        for (int ks = 1; ks < 4; ++ks) { A2_MF(sA, ka[ks], qf[ks]); A2_MF(sB, kbq[ks], qf[ks]); }
        asm volatile("s_nop 15\n\ts_nop 7" : "+v"(sA), "+v"(sB));
        float a = max3c(sA[0], sB[0], sA[1]), c = max3c(sB[1], sA[2], sB[2]);
#pragma unroll
        for (int r = 3; r < 15; r += 2) { a = max3c(a, sA[r], sB[r]); c = max3c(c, sA[r + 1], sB[r + 1]); }
        a = max3c(a, sA[15], sB[15]); rmn = max3c(a, c, c);
#pragma unroll
        for (int r = 0; r < 16; ++r) { nA[r] = 0.f; nB[r] = 0.f; }
    }
#define A2_STEP(CA, CB, NA, NB, T_) do { const int t_ = (T_); \
        if (t_ + 3 < nta) ATT_DMA(t_ + 3, (t_ + 3) & 3); \
        if (t_ < ntw) { \
            const LAS unsigned char* kbn = lds + ((t_ + 1) & 3) * 32768 + kb0; const LAS unsigned char* vbp = lds + (t_ & 3) * 32768 + 16384 + vb0; \
            bf16x8 k0a, k0b, k1a, k1b, k2a, k2b, k3a, k3b, va0, va1, va2, va3, vc0, vc1, vc2, vc3; u32x4 pw0, pw1, pw2, pw3; \
            A2_KLD(k0a, k0b, kbn, 0); A2_KLD(k1a, k1b, kbn, 1); A2_VLD(va0, vbp, 0, 0); A2_VLD(va1, vbp, 1, 0); A2_VLD(va2, vbp, 2, 0); A2_VLD(va3, vbp, 3, 0); \
            float rm = rmn; \
            { auto rr = __builtin_amdgcn_permlane32_swap(__builtin_bit_cast(unsigned, rm), __builtin_bit_cast(unsigned, rm), false, false); rm = fmaxf(__builtin_bit_cast(float, rr[0]), __builtin_bit_cast(float, rr[1])); } \
            if (t_ == 0) { mrun = rm; \
                _Pragma("unroll") for (int r = 0; r < 16; ++r) { CA[r] -= rm; CB[r] -= rm; negm[r] = -rm; } \
            } else if (__any(rm > 8.0f)) { \
                const float dl = fmaxf(rm, 0.f), al = __builtin_amdgcn_exp2f(-dl); mrun += dl; lsA *= al; lsB *= al; \
                _Pragma("unroll") for (int r = 0; r < 16; ++r) { CA[r] -= dl; CB[r] -= dl; negm[r] = -mrun; o0[r] *= al; o1[r] *= al; o2[r] *= al; o3[r] *= al; } } \
              \
            A2_EX(CA, 0); A2_EX(CA, 2); A2_EX(CA, 4); A2_EX(CA, 6); \
            pw0.x = cvtpk_c(CA[0], CA[1]); pw0.y = cvtpk_c(CA[2], CA[3]); pw0.z = cvtpk_c(CA[4], CA[5]); pw0.w = cvtpk_c(CA[6], CA[7]); A2_SB(); \
            NA = __builtin_amdgcn_mfma_f32_32x32x16_bf16(k0a, qf[0], negm, 0, 0, 0); A2_EX(CA, 8); A2_KLD(k2a, k2b, kbn, 2); A2_SB(); \
            NB = __builtin_amdgcn_mfma_f32_32x32x16_bf16(k0b, qf[0], negm, 0, 0, 0); A2_EX(CA, 10); A2_KLD(k3a, k3b, kbn, 3); A2_SB(); \
            A2_MF(NA, k1a, qf[1]); A2_EX(CA, 12); A2_SB(); \
            A2_MF(NB, k1b, qf[1]); A2_EX(CA, 14); A2_SB(); \
            A2_MF(NA, k2a, qf[2]); pw1.x = cvtpk_c(CA[8], CA[9]); pw1.y = cvtpk_c(CA[10], CA[11]); A2_VLD(vc0, vbp, 0, 1); A2_VLD(vc1, vbp, 1, 1); A2_SB(); \
            A2_MF(NB, k2b, qf[2]); pw1.z = cvtpk_c(CA[12], CA[13]); pw1.w = cvtpk_c(CA[14], CA[15]); A2_VLD(vc2, vbp, 2, 1); A2_VLD(vc3, vbp, 3, 1); A2_SB(); \
            A2_MF(NA, k3a, qf[3]); A2_EX(CB, 0); A2_SB(); \
            A2_MF(NB, k3b, qf[3]); A2_EX(CB, 2); A2_SB(); \
            A2_MF(o0, va0, A2_PB(0)); A2_EX(CB, 4); A2_SB(); \
            A2_MF(o1, va1, A2_PB(0)); A2_EX(CB, 6); A2_SB(); \
            A2_MF(o2, va2, A2_PB(0)); A2_EX(CB, 8); pw2.x = cvtpk_c(CB[0], CB[1]); pw2.y = cvtpk_c(CB[2], CB[3]); A2_SB(); \
            A2_MF(o3, va3, A2_PB(0)); A2_EX(CB, 10); pw2.z = cvtpk_c(CB[4], CB[5]); pw2.w = cvtpk_c(CB[6], CB[7]); A2_SB(); \
            A2_MF(o0, vc0, A2_PB(1)); A2_EX(CB, 12); A2_VLD(va0, vbp, 0, 2); A2_VLD(va1, vbp, 1, 2); A2_SB(); \
            A2_MF(o1, vc1, A2_PB(1)); A2_EX(CB, 14); A2_VLD(va2, vbp, 2, 2); A2_VLD(va3, vbp, 3, 2); A2_SB(); \
            A2_MF(o2, vc2, A2_PB(1)); pw3.x = cvtpk_c(CB[8], CB[9]); pw3.y = cvtpk_c(CB[10], CB[11]); A2_SB(); \
            A2_MF(o3, vc3, A2_PB(1)); pw3.z = cvtpk_c(CB[12], CB[13]); pw3.w = cvtpk_c(CB[14], CB[15]); A2_SB(); \
            float ma, mc; \
            A2_MF(o0, va0, A2_PB(2)); A2_VLD(vc0, vbp, 0, 3); A2_VLD(vc1, vbp, 1, 3); ma = max3c(NA[0], NB[0], NA[1]); mc = max3c(NB[1], NA[2], NB[2]); A2_SB(); \
            A2_MF(o1, va1, A2_PB(2)); A2_VLD(vc2, vbp, 2, 3); A2_VLD(vc3, vbp, 3, 3); ma = max3c(ma, NA[3], NB[3]); mc = max3c(mc, NA[4], NB[4]); A2_SB(); \
            A2_MF(o2, va2, A2_PB(2)); ma = max3c(ma, NA[5], NB[5]); mc = max3c(mc, NA[6], NB[6]); A2_SB(); \
            A2_MF(o3, va3, A2_PB(2)); ma = max3c(ma, NA[7], NB[7]); mc = max3c(mc, NA[8], NB[8]); A2_SB(); \
            A2_MF(o0, vc0, A2_PB(3)); ma = max3c(ma, NA[9], NB[9]); mc = max3c(mc, NA[10], NB[10]); A2_SB(); \
            A2_MF(o1, vc1, A2_PB(3)); ma = max3c(ma, NA[11], NB[11]); mc = max3c(mc, NA[12], NB[12]); A2_SB(); \
            A2_MF(o2, vc2, A2_PB(3)); ma = max3c(ma, NA[13], NB[13]); mc = max3c(mc, NA[14], NB[14]); A2_SB(); \
            A2_MF(o3, vc3, A2_PB(3)); ma = max3c(ma, NA[15], NB[15]); rmn = max3c(ma, mc, mc); A2_SB(); \
        } \
        if (t_ + 3 < nta) asm volatile("s_waitcnt vmcnt(4) lgkmcnt(0)" ::: "memory"); else asm volatile("s_waitcnt vmcnt(0) lgkmcnt(0)" ::: "memory"); \
        __builtin_amdgcn_s_barrier(); asm volatile("" ::: "memory"); } while (0)
    for (int t = 0; t < nta; t += 2) {
        A2_STEP(sA, sB, nA, nB, t);
        A2_STEP(nA, nB, sA, sB, t + 1);
    }
#undef A2_STEP
#undef A2_SB
#undef A2_MF
#undef A2_KLD
#undef A2_VLD
#undef A2_EX
#undef A2_PB
#undef ATT_DMA
    float lt = lsA + lsB; lt += shx(lt, 32, lane);
    LAS float* xch = (LAS float*)(lds + 65536 + wq * 16384) + lane;
    if (j == 1) { const float i1 = lam / lt;
#pragma unroll
        for (int r = 0; r < 16; ++r) { xch[(0 * 16 + r) * 64] = o0[r] * i1; xch[(1 * 16 + r) * 64] = o1[r] * i1; xch[(2 * 16 + r) * 64] = o2[r] * i1; xch[(3 * 16 + r) * 64] = o3[r] * i1; } }
    __syncthreads();
    if (j == 0) { const float i0 = 1.0f / lt; float ssq = 0.f;
#pragma unroll
        for (int r = 0; r < 16; ++r) { float c;
            c = o0[r] * i0 - xch[(0 * 16 + r) * 64]; o0[r] = c; ssq += c * c; c = o1[r] * i0 - xch[(1 * 16 + r) * 64]; o1[r] = c; ssq += c * c;
            c = o2[r] * i0 - xch[(2 * 16 + r) * 64]; o2[r] = c; ssq += c * c; c = o3[r] * i0 - xch[(3 * 16 + r) * 64]; o3[r] = c; ssq += c * c; }
        ssq += shx(ssq, 32, lane);
        const float rs = outscale / sqrtf(ssq * (1.0f / 128.0f) + EPS);
        bf16_t* yp = Y + (tok0 + q0 + i32) * 1024 + 512 + h * 128;
#define A2_ST(OX, eb) _Pragma("unroll") for (int rq = 0; rq < 4; ++rq) { const int e0 = 32 * (eb) + 8 * rq + 4 * hi; const f32x4 gq = *(const f32x4*)(subg + e0); \
            u32x2 w; w.x = cvtpk_c(OX[4 * rq] * rs * gq[0], OX[4 * rq + 1] * rs * gq[1]); w.y = cvtpk_c(OX[4 * rq + 2] * rs * gq[2], OX[4 * rq + 3] * rs * gq[3]); *(u32x2*)(yp + e0) = w; }
        A2_ST(o0, 0) A2_ST(o1, 1) A2_ST(o2, 2) A2_ST(o3, 3)
#undef A2_ST
    }
    __syncthreads();
}

#ifndef PROBE_GEMM_REPS
#define PROBE_GEMM_REPS 1
#endif
__global__ void __launch_bounds__(512, 2) mk_fwd(Args args) {
    extern __shared__ __attribute__((aligned(16))) unsigned char lds_raw[];
    LAS unsigned char* lds = (LAS unsigned char*)lds_raw;
    const int wid = __builtin_amdgcn_readfirstlane((int)threadIdx.x >> 6);
    const int G = gridDim.x, bx = blockIdx.x;
    const float* x = args.in[0]; float* out = args.out;
#define PHASE_PTRS() \
    unsigned char* ws = args.ws; int bxl = bx; asm volatile("" : "+s"(ws), "+s"(bxl)); int lanel = pg8::lane_id_opaque(); asm volatile("" : "+v"(lanel)); (void)lanel; \
    const int vcu = (G % 8 == 0) ? (bxl % 8) * (G / 8) + bxl / 8 : bxl; const int gw = vcu * 8 + wid, ngw = G * 8; (void)gw; (void)ngw; \
    float* rope = (float*)(ws + WS_ROPE); float* rinv = (float*)(ws + WS_RINV); float* ssp = (float*)(ws + WS_SSP); bf16_t* wsg = (bf16_t*)(ws + WS_WSG); \
    bf16_t* XN = (bf16_t*)(ws + WS_XN); bf16_t* MIX = (bf16_t*)(ws + WS_MIX); bf16_t* U = (bf16_t*)(ws + WS_U); bf16_t* VG = (bf16_t*)(ws + WS_VG); \
    bf16_t* Qb = (bf16_t*)(ws + WS_Q); bf16_t* Kb = (bf16_t*)(ws + WS_K); bf16_t* VT = (bf16_t*)(ws + WS_VT); bf16_t* Y = (bf16_t*)(ws + WS_Y); bf16_t* H = (bf16_t*)(ws + WS_H); \
    (void)rope; (void)rinv; (void)ssp; (void)wsg; (void)XN; (void)MIX; (void)U; (void)VG; (void)Qb; (void)Kb; (void)VT; (void)Y; (void)H;
    cg::grid_group grid = cg::this_grid();
    volatile LAS unsigned* misc = (volatile LAS unsigned*)(lds + 131072 + 1024);
    if (XB_T0(wid)) { misc[0] = 0u; misc[1] = 0u; }
    __syncthreads();
    XcdBarrier bar = xcd_barrier_post((unsigned*)args.ws + 4096, misc, wid);

    const int lo = args.ph_lo, hi = args.ph_hi;
#define IN(k) (lo <= (k) && (k) < hi)
#define SEAM(k) do { if (IN(k) && IN((k) + 1)) xcd_barrier(bar); } while (0)
    if (hi > NPHASE) grid.sync();
    {
        if (IN(0)) { PHASE_PTRS();
#ifndef PROBE_PRO_REPS
#define PROBE_PRO_REPS 1
#endif
            for (int rep = 0; rep < PROBE_PRO_REPS; ++rep) {
            LAS float* scr = (LAS float*)(lds + wid * 16384);
            constexpr int I_IN = 16 * 80, I_OUT = 16 * 32, I_GU = 16 * 176, I_D = 44 * 32, I_L = I_IN + I_OUT + I_GU + I_D;
            for (int it = gw; it < DEPTH * I_L; it += ngw) {
                const int l = it / I_L; int r = it % I_L; unsigned char* wl = ws + WS_W0 + (size_t)l * W_LAYER;
                if (r < I_IN) { const int kb = r / 80, nb = r % 80; transpose_item(args.in[2] + (size_t)l * DM * INW, DM, INW, args.in[1] + l * DM, (bf16_t*)(wl + WO_IN), kb, 32 * nb, win_src(32 * nb), scr, lanel); continue; } r -= I_IN;
                if (r < I_OUT) { const int kb = r / 32, nb = r % 32; transpose_item(args.in[12] + (size_t)l * DM * DM, DM, DM, nullptr, (bf16_t*)(wl + WO_OUT), kb, 32 * nb, 32 * nb, scr, lanel); continue; } r -= I_OUT;
                if (r < I_GU) { const int kb = r / 176, nb = r % 176; transpose_item(args.in[15] + (size_t)l * DM * GU, DM, GU, args.in[14] + l * DM, (bf16_t*)(wl + WO_GU), kb, 32 * nb, wgu_src(32 * nb), scr, lanel); continue; } r -= I_GU;
                { const int kb = r / 32, nb = r % 32; transpose_item(args.in[16] + (size_t)l * FF * DM, FF, DM, nullptr, (bf16_t*)(wl + WO_D), kb, 32 * nb, 32 * nb, scr, lanel); }
            }
            for (int i = gw * 64 + lanel; i < DEPTH * 4 * 128 * 128; i += ngw * 64) { const int s = i & 127, t = (i >> 7) & 127; const float w = args.in[5][i]; wsg[i] = (bf16_t)f2bf(((s >> 6) <= (t >> 6)) ? w : 0.f); }
            for (int i = gw * 64 + lanel; i < SEQ * 32; i += ngw * 64) { const int pos = i >> 5, f = i & 31; const float ang = (float)pos * args.inv_freq[f];
                double rev = (double)ang * 0.15915494309189535; rev -= floor(rev); const float rf = (float)rev;
                rope[2 * i] = __builtin_amdgcn_cosf(rf); rope[2 * i + 1] = __builtin_amdgcn_sinf(rf); }
            for (int m0 = gw * 4; m0 < M; m0 += ngw * 4) {
                f32x4 v[4][4];
#pragma unroll
                for (int i = 0; i < 4; ++i)
#pragma unroll
                    for (int jj = 0; jj < 4; ++jj) v[i][jj] = *((const f32x4*)(x + (size_t)(m0 + i) * DM) + lanel + 64 * jj);
#pragma unroll
                for (int i = 0; i < 4; ++i) { float s = 0.f; u32x2* o8 = (u32x2*)(XN + (size_t)(m0 + i) * DM) + lanel;
#pragma unroll
                    for (int jj = 0; jj < 4; ++jj) { const f32x4 t = v[i][jj]; s += (t[0] * t[0] + t[1] * t[1]) + (t[2] * t[2] + t[3] * t[3]); u32x2 w; w.x = pk2(t[0], t[1]); w.y = pk2(t[2], t[3]); o8[64 * jj] = w; }
                    s = wave_sum(s, lanel);
                    if (lanel == 0) rinv[m0 + i] = 1.0f / sqrtf(s * (1.0f / DM) + EPS); }
            }
            }
            __syncthreads();
        }
        SEAM(0);
#pragma unroll
        for (int l = 0; l < DEPTH; ++l) {
            const int p0 = 1 + 7 * l;
#define WL() unsigned char* wl = ws + WS_W0 + (size_t)l * W_LAYER
            if (IN(p0)) { PHASE_PTRS(); WL();
                { pg8::Gemm g{XN, (const bf16_t*)(wl + WO_IN), M, 2048, DM}; pg8::StaticOrder S; S.init(M, 2048, G, bxl);
                  pg8::EpiIn E{U, VG, Qb, Kb, rinv, rope, QSCALE};

#ifndef SKIP_G1A
                  for (int rep = 0; rep < PROBE_GEMM_REPS; ++rep) pg8::gemm_phase<pg8::EpiIn, pg8::StaticOrder, true, true>(lds, g, S, E, wid);
#endif
 }
                { pg8::Gemm g{(const bf16_t*)(wl + WO_IN) + (size_t)2048 * DM, XN, 512, M, DM}; pg8::StaticOrder S; S.init(512, M, G, bxl);
                  pg8::EpiVT E{VT, M, rinv};

#ifndef SKIP_G1B
                  for (int rep = 0; rep < PROBE_GEMM_REPS; ++rep) pg8::gemm_phase<pg8::EpiVT, pg8::StaticOrder, true, true>(lds, g, S, E, wid);
#endif
 }
            }
            SEAM(p0);
            if (IN(p0 + 1)) { PHASE_PTRS();
                const float lam0 = args.lam_init[l];
                const float a = wave_sum(args.in[7][l * 64 + lanel] * args.in[8][l * 64 + lanel], lanel), bq = wave_sum(args.in[9][l * 64 + lanel] * args.in[10][l * 64 + lanel], lanel);
                const float lam = __builtin_bit_cast(float, __builtin_amdgcn_readfirstlane(__builtin_bit_cast(int, expf(a) - expf(bq) + lam0)));
#ifndef PROBE_ATTN_REPS
#define PROBE_ATTN_REPS 1
#endif
                for (int rep = 0; rep < PROBE_ATTN_REPS; ++rep)
                for (int p = vcu; p < 256; p += G) {
                    const int xcd = p >> 5, c = p & 31;
#ifndef SKIP_ATTN
#pragma unroll 1
                    for (int i = 0; i < 4; ++i) { const int bh = 2 * xcd + (i >> 1), qb = (i & 1) ? c : 63 - c;
                        attn_unit2(lds, Qb, Kb, VT, Y, args.in[11] + l * 128, lam, 1.0f - lam0, bh >> 2, bh & 3, qb, wid); }
#endif
                }
#ifndef SKIP_GMLP
#ifndef PROBE_GMLP_REPS
#define PROBE_GMLP_REPS 1
#endif
                for (int rep = 0; rep < PROBE_GMLP_REPS; ++rep)
                for (int blk = vcu; blk < M / 128; blk += G)
                    gmlp_unit(lds, U, VG, wsg + (size_t)l * 4 * 128 * 128, args.in[3] + l * 512, args.in[4] + l * 512, args.in[6] + l * 512, Y, blk, wid);
#endif
            }
            SEAM(p0 + 1);
            if (IN(p0 + 2)) { PHASE_PTRS(); WL();
                pg8::Gemm g{Y, (const bf16_t*)(wl + WO_OUT), M, DM, DM}; pg8::StaticOrder S; S.init(M, DM, G, bxl);
                pg8::EpiSS E{MIX, ssp};

#ifndef SKIP_G2
                  for (int rep = 0; rep < PROBE_GEMM_REPS; ++rep) pg8::gemm_phase<pg8::EpiSS, pg8::StaticOrder, true, true>(lds, g, S, E, wid);
#endif

            }
            SEAM(p0 + 2);
            if (IN(p0 + 3)) { PHASE_PTRS();
                res_phase<2>(nullptr, MIX, ssp, args.in[13] + l * DM, XN, rinv, gw, ngw, lanel);
            }
            SEAM(p0 + 3);
            if (IN(p0 + 4)) { PHASE_PTRS(); WL();
                pg8::Gemm g{XN, (const bf16_t*)(wl + WO_GU), M, GU, DM}; pg8::StaticOrder S; S.init(M, GU, G, bxl);
                pg8::EpiGU E{H, FF, rinv};

#ifndef SKIP_G3
                  for (int rep = 0; rep < PROBE_GEMM_REPS; ++rep) pg8::gemm_phase<pg8::EpiGU, pg8::StaticOrder, true, true>(lds, g, S, E, wid);
#endif

            }
            SEAM(p0 + 4);
            if (IN(p0 + 5)) { PHASE_PTRS(); WL();
                pg8::Gemm g{H, (const bf16_t*)(wl + WO_D), M, DM, FF}; pg8::StaticOrder S; S.init(M, DM, G, bxl);
                pg8::EpiSS E{MIX, ssp};

#ifndef SKIP_G2
                  for (int rep = 0; rep < PROBE_GEMM_REPS; ++rep) pg8::gemm_phase<pg8::EpiSS, pg8::StaticOrder, true, true>(lds, g, S, E, wid);
#endif

            }
            SEAM(p0 + 5);
            if (IN(p0 + 6)) { PHASE_PTRS();
                res_phase<2>(l == DEPTH - 1 ? out : nullptr, MIX, ssp, args.in[17] + l * DM, XN, rinv, gw, ngw, lanel);
            }
            SEAM(p0 + 6);
        }
    }
#undef IN
#undef SEAM
#undef PHASE_PTRS
#undef WL
}
}

#ifndef MK_MULTI
#define MK_MULTI 0
#endif
extern "C" void kernel_launch(void* const* d_in, const int* in_sizes, int n_in, void* d_out, int out_size, void* d_ws, size_t ws_size, hipStream_t stream) {
    using namespace mk;
    static int grid = 0;
    if (grid == 0) {
        if (n_in != 18 || out_size != M * DM || ws_size < WS_END) { fprintf(stderr, "kernel_launch: unexpected problem (n_in %d out %d ws %zu)\n", n_in, out_size, ws_size); grid = -1; return; }
        int dev = 0, cus = 0, per_cu = 0;
        hipGetDevice(&dev); hipDeviceGetAttribute(&cus, hipDeviceAttributeMultiprocessorCount, dev);
        if (hipFuncSetAttribute((const void*)mk_fwd, hipFuncAttributeMaxDynamicSharedMemorySize, LDS_BYTES) != hipSuccess) { fprintf(stderr, "kernel_launch: hipFuncSetAttribute failed\n"); grid = -1; return; }
        hipOccupancyMaxActiveBlocksPerMultiprocessor(&per_cu, (const void*)mk_fwd, 512, LDS_BYTES);
        if (per_cu < 1) { fprintf(stderr, "kernel_launch: occupancy query says %d blocks/CU\n", per_cu); per_cu = 1; }
        (void)hipGetLastError();
        grid = cus;
    }
    if (grid < 0) return;
    if (hipMemsetAsync(d_ws, 0, 65536, stream) != hipSuccess) { fprintf(stderr, "kernel_launch: hipMemsetAsync failed\n"); return; }
    Args a{};
    for (int i = 0; i < 18; ++i) a.in[i] = (const float*)d_in[i];
    a.out = (float*)d_out; a.ws = (unsigned char*)d_ws;
    for (int i = 0; i < 32; ++i) a.inv_freq[i] = 1.0f / powf(10000.0f, (float)(2 * i) / 64.0f);
    for (int l = 0; l < 2; ++l) a.lam_init[l] = (float)(0.8 - 0.6 * exp(-0.3 * (double)l));
#if MK_MULTI
    for (int ph = 0; ph < NPHASE; ++ph) { a.ph_lo = ph; a.ph_hi = ph + 1; hipLaunchKernelGGL(mk_fwd, dim3(grid), dim3(512), LDS_BYTES, stream, a); }
#else
    a.ph_lo = 0; a.ph_hi = NPHASE;
    void* kargs[] = {&a};
    hipError_t e = hipLaunchCooperativeKernel((const void*)mk_fwd, dim3(grid), dim3(512), kargs, LDS_BYTES, stream);
    if (e != hipSuccess) fprintf(stderr, "cooperative launch failed: %s (grid %d)\n", hipGetErrorString(e), grid);
#endif
}
```
